# Optimizing an MI355X kernel written in HIP

```python
import math
import functools
import jax
import jax.numpy as jnp
from jax import lax
import numpy as np

D_MODEL = 1024
BATCH = 16
SEQ = 2048
DEPTH = 2

GRID_W = 64
CTX_LEN = 256
N_EVEN = (DEPTH + 1) // 2
N_ODD = DEPTH // 2
EPS = 1e-6

GLA_HEADS = 4
GLA_DK = D_MODEL // 16
GLA_DV = D_MODEL // 8
GLA_RANK = 16
GLA_TAU = 16.0
GLA_CHUNK = 64

ML_HEADS = 4
ML_D = D_MODEL // 8
ML_CONV = 3
ML_CHUNK = 64

D_INNER = 2 * D_MODEL
SSD_HEADDIM = 64
SSD_HEADS = D_INNER // SSD_HEADDIM
SSD_GROUPS = 4
SSD_HPG = SSD_HEADS // SSD_GROUPS
SSD_STATE = 128
SSD_CONV = 3
SSD_CHUNK = 128

D_FF = 2816
FFN_CONV = 3

GLA_QK = GLA_HEADS * GLA_DK
GLA_V = GLA_HEADS * GLA_DV
ML_W = ML_HEADS * ML_D
EVEN_SIZES = (GLA_QK, GLA_QK, GLA_V, GLA_V, ML_W, ML_W, ML_W, ML_W, 4 * ML_HEADS)
EVEN_IN = sum(EVEN_SIZES)
SSD_BC = SSD_GROUPS * SSD_STATE
SSD_CONV_CH = D_INNER + 2 * SSD_BC
ODD_SIZES = (D_INNER, SSD_CONV_CH, 2 * SSD_HEADS)
ODD_IN = sum(ODD_SIZES)

kernel_name = 'hybrid_gla_mlstm_ssd_prefix_dit'


def _split(a, sizes):
    return jnp.split(a, [int(s) for s in np.cumsum(sizes)[:-1]], axis=-1)


def rmsnorm(x, g):
    xf = x.astype(jnp.float32)
    y = xf * lax.rsqrt(jnp.mean(xf * xf, axis=-1, keepdims=True) + EPS)
    return (y * g.astype(jnp.float32)).astype(x.dtype)


def modulate(x, g, shift, scale):
    return rmsnorm(x, g) * (1 + scale) + shift


def dwconv1d(x, w, b):
    k_w = w.shape[0]
    t = x.shape[1]
    pad = k_w // 2
    xp = jnp.pad(x, ((0, 0), (pad, pad), (0, 0)))
    return sum(xp[:, j:j + t] * w[j] for j in range(k_w)) + b


def dwconv2d_grid(x, w, b, rows):
    bsz, t, ch = x.shape
    y = lax.conv_general_dilated(x.reshape(bsz, rows, GRID_W, ch), w[:, :, None, :], (1, 1), 'SAME',
                                 dimension_numbers=('NHWC', 'HWIO', 'NHWC'), feature_group_count=ch)
    return y.reshape(bsz, t, ch) + b


def to_chunks(a, size):
    bsz, t = a.shape[:2]
    return jnp.moveaxis(a.reshape(bsz, t // size, size, *a.shape[2:]), 1, 0)


def from_chunks(a):
    a = jnp.moveaxis(a, 0, 1)
    return a.reshape(a.shape[0], a.shape[1] * a.shape[2], *a.shape[3:])


def gla_scan(q, k, v, log_a, s0, with_out):
    size = GLA_CHUNK
    tri = jnp.tril(jnp.ones((size, size), dtype=bool))[None, :, :, None, None]

    def step(s, inp):
        qc, kc, vc, lac = inp
        cum = jnp.cumsum(lac.astype(jnp.float32), axis=1)
        c_end = cum[:, -1]
        k_end = kc * jnp.exp(c_end[:, None] - cum)
        s_new = jnp.exp(c_end)[..., None] * s + jnp.einsum('bshk,bshv->bhkv', k_end, vc)
        if not with_out:
            return s_new, None
        rel = jnp.where(tri, cum[:, :, None] - cum[:, None, :], -jnp.inf)
        att = jnp.einsum('bthk,bshk,btshk->bhts', qc, kc, jnp.exp(rel))
        o = jnp.einsum('bhts,bshv->bthv', att, vc) + jnp.einsum('bthk,bhkv->bthv', qc * jnp.exp(cum), s)
        return s_new, o

    s, o = lax.scan(step, s0, tuple(to_chunks(a, size) for a in (q, k, v, log_a)))
    return (from_chunks(o) if with_out else None), s


def mlstm_scan(q, k, v, li, lf, state0, with_out):
    size = ML_CHUNK
    tri = jnp.tril(jnp.ones((size, size), dtype=bool))[None, :, :, None]

    def step(carry, inp):
        cmat, nvec, m = carry
        qc, kc, vc, lic, lfc = inp
        b = jnp.cumsum(lfc, axis=1)
        b_end = b[:, -1]
        w_end = b_end[:, None] - b + lic
        m_new = jnp.maximum(b_end + m, jnp.max(w_end, axis=1))
        decay = jnp.exp(b_end + m - m_new)
        ws = jnp.exp(w_end - m_new[:, None])
        c_new = decay[..., None, None] * cmat + jnp.einsum('bsh,bshk,bshv->bhkv', ws, kc, vc)
        n_new = decay[..., None] * nvec + jnp.einsum('bsh,bshk->bhk', ws, kc)
        if not with_out:
            return (c_new, n_new, m_new), None
        a_in = b + m[:, None]
        d_log = jnp.where(tri, b[:, :, None] - b[:, None, :] + lic[:, None, :], -jnp.inf)
        m_t = jnp.maximum(a_in, jnp.max(d_log, axis=2))
        dw = jnp.exp(d_log - m_t[:, :, None])
        aw = jnp.exp(a_in - m_t)
        sc = jnp.einsum('bthk,bshk->btsh', qc, kc) * dw
        num = aw[..., None] * jnp.einsum('bthk,bhkv->bthv', qc, cmat) + jnp.einsum('btsh,bshv->bthv', sc, vc)
        den = aw * jnp.einsum('bthk,bhk->bth', qc, nvec) + jnp.sum(sc, axis=2)
        h = num / jnp.maximum(jnp.abs(den), jnp.exp(-m_t))[..., None]
        return (c_new, n_new, m_new), h

    state, h = lax.scan(step, state0, tuple(to_chunks(a, size) for a in (q, k, v, li, lf)))
    return (from_chunks(h) if with_out else None), state


def ssd_scan(x, dt, bm, cm, s0, with_out, A):
    size = SSD_CHUNK
    tri = jnp.tril(jnp.ones((size, size), dtype=bool))[None, :, :, None, None]

    def step(s, inp):
        xc, dtc, bc, cc = inp
        cum = jnp.cumsum(dtc * A, axis=1)
        c_end = cum[:, -1]
        w_end = jnp.exp(c_end[:, None] - cum) * dtc
        s_new = jnp.exp(c_end)[..., None, None] * s + jnp.einsum('bsgh,bsgn,bsghp->bghpn', w_end, bc, xc)
        if not with_out:
            return s_new, None
        seg = jnp.where(tri, cum[:, :, None] - cum[:, None, :], -jnp.inf)
        cb = jnp.einsum('btgn,bsgn->btsg', cc, bc)
        w = jnp.exp(seg) * cb[..., None] * dtc[:, None]
        y = (jnp.einsum('btsgh,bsghp->btghp', w, xc)
             + jnp.exp(cum)[..., None] * jnp.einsum('btgn,bghpn->btghp', cc, s))
        return s_new, y

    s, y = lax.scan(step, s0, tuple(to_chunks(a, size) for a in (x, dt, bm, cm)))
    return (from_chunks(y) if with_out else None), s


def bidir_scan(scan_f, scan_b, ctx_f, lat_f, ctx_b, lat_b, init, ctx_out):
    def one_dir(scan_fn, ctx_args, lat_args):
        yc, s_ctx = scan_fn(*ctx_args, init, ctx_out)
        yl, _ = scan_fn(*lat_args, s_ctx, True)
        return yc, yl

    def rev(a):
        return jnp.flip(a, axis=1)

    yc_f, yl_f = one_dir(scan_f, ctx_f, lat_f)
    yc_b, yl_b = one_dir(scan_b, [rev(a) for a in ctx_b], [rev(a) for a in lat_b])
    yl = yl_f + rev(yl_b)
    yc = (yc_f + rev(yc_b)) if ctx_out else None
    return yc, yl


def even_features(h, w_in, a1, a2, ab, conv_w, conv_b, gate_b):
    bsz, t, _ = h.shape
    gq, gk, gv, gg, mq, mk, mv, mo, mg = _split(h @ w_in, EVEN_SIZES)
    log_a = [(jax.nn.log_sigmoid(((h @ a1[d]) @ a2[d] + ab[d]).astype(jnp.float32)) / GLA_TAU)
             .reshape(bsz, t, GLA_HEADS, GLA_DK) for d in range(2)]
    qk = jax.nn.silu(dwconv1d(jnp.concatenate([mq, mk], axis=-1), conv_w, conv_b))
    mq, mk = jnp.split(qk, 2, axis=-1)
    gates = (mg + gate_b).astype(jnp.float32).reshape(bsz, t, 4, ML_HEADS)
    return {
        'gla_q': gq.reshape(bsz, t, GLA_HEADS, GLA_DK) * GLA_DK ** -0.5,
        'gla_k': gk.reshape(bsz, t, GLA_HEADS, GLA_DK),
        'gla_v': gv.reshape(bsz, t, GLA_HEADS, GLA_DV),
        'gla_g': gg,
        'la_f': log_a[0], 'la_b': log_a[1],
        'ml_q': mq.reshape(bsz, t, ML_HEADS, ML_D),
        'ml_k': mk.reshape(bsz, t, ML_HEADS, ML_D) * ML_D ** -0.5,
        'ml_v': mv.reshape(bsz, t, ML_HEADS, ML_D),
        'ml_o': mo,
        'li_f': gates[:, :, 0], 'lf_f': jax.nn.log_sigmoid(gates[:, :, 1]),
        'li_b': gates[:, :, 2], 'lf_b': jax.nn.log_sigmoid(gates[:, :, 3]),
    }


def even_combine(f, o_gla, h_ml, gla_norm_g, ml_norm_g, w_out):
    bsz, t = o_gla.shape[:2]
    gla = rmsnorm(o_gla, gla_norm_g.reshape(GLA_HEADS, GLA_DV)).reshape(bsz, t, GLA_V) * jax.nn.silu(f['gla_g'])
    ml = jax.nn.sigmoid(f['ml_o']).reshape(bsz, t, ML_HEADS, ML_D) * h_ml
    ml = rmsnorm(ml, ml_norm_g.reshape(ML_HEADS, ML_D)).reshape(bsz, t, ML_W)
    return jnp.concatenate([gla, ml], axis=-1).astype(w_out.dtype) @ w_out


def even_mixer(hc, hl, w_in, a1, a2, ab, conv_w, conv_b, gate_b, gla_norm_g, ml_norm_g, w_out, ctx_out):
    fc = even_features(hc, w_in, a1, a2, ab, conv_w, conv_b, gate_b)
    fl = even_features(hl, w_in, a1, a2, ab, conv_w, conv_b, gate_b)
    bsz = hl.shape[0]

    def g_args(f, d):
        return (f['gla_q'], f['gla_k'], f['gla_v'], f['la_' + d])

    gla_init = jnp.zeros((bsz, GLA_HEADS, GLA_DK, GLA_DV), jnp.float32)
    oc_gla, ol_gla = bidir_scan(gla_scan, gla_scan, g_args(fc, 'f'), g_args(fl, 'f'),
                                g_args(fc, 'b'), g_args(fl, 'b'), gla_init, ctx_out)

    def m_args(f, d):
        return (f['ml_q'], f['ml_k'], f['ml_v'], f['li_' + d], f['lf_' + d])

    ml_init = (jnp.zeros((bsz, ML_HEADS, ML_D, ML_D), jnp.float32),
               jnp.zeros((bsz, ML_HEADS, ML_D), jnp.float32),
               jnp.zeros((bsz, ML_HEADS), jnp.float32))
    hc_ml, hl_ml = bidir_scan(mlstm_scan, mlstm_scan, m_args(fc, 'f'), m_args(fl, 'f'),
                              m_args(fc, 'b'), m_args(fl, 'b'), ml_init, ctx_out)
    yl = even_combine(fl, ol_gla, hl_ml, gla_norm_g, ml_norm_g, w_out)
    yc = even_combine(fc, oc_gla, hc_ml, gla_norm_g, ml_norm_g, w_out) if ctx_out else None
    return yc, yl


def odd_features(h, w_in, conv_w, conv_b, dt_bias):
    bsz, t, _ = h.shape
    z, xbc, dt = _split(h @ w_in, ODD_SIZES)
    xs, bm, cm = _split(jax.nn.silu(dwconv1d(xbc, conv_w, conv_b)), (D_INNER, SSD_BC, SSD_BC))
    dt = jax.nn.softplus(dt.astype(jnp.float32).reshape(bsz, t, 2, SSD_HEADS) + dt_bias.astype(jnp.float32))
    dt = dt.reshape(bsz, t, 2, SSD_GROUPS, SSD_HPG)
    return {
        'z': z,
        'x': xs.reshape(bsz, t, SSD_GROUPS, SSD_HPG, SSD_HEADDIM),
        'b': bm.reshape(bsz, t, SSD_GROUPS, SSD_STATE),
        'c': cm.reshape(bsz, t, SSD_GROUPS, SSD_STATE),
        'dt_f': dt[:, :, 0], 'dt_b': dt[:, :, 1],
    }


def odd_mixer(hc, hl, w_in, conv_w, conv_b, dt_bias, a_log, d_skip, norm_g, w_out, ctx_out):
    fc = odd_features(hc, w_in, conv_w, conv_b, dt_bias)
    fl = odd_features(hl, w_in, conv_w, conv_b, dt_bias)
    bsz = hl.shape[0]
    A = -jnp.exp(a_log.astype(jnp.float32)).reshape(2, SSD_GROUPS, SSD_HPG)
    scan_f = functools.partial(ssd_scan, A=A[0])
    scan_b = functools.partial(ssd_scan, A=A[1])

    def s_args(f, d):
        return (f['x'], f['dt_' + d], f['b'], f['c'])

    init = jnp.zeros((bsz, SSD_GROUPS, SSD_HPG, SSD_HEADDIM, SSD_STATE), jnp.float32)
    yc, yl = bidir_scan(scan_f, scan_b, s_args(fc, 'f'), s_args(fl, 'f'),
                        s_args(fc, 'b'), s_args(fl, 'b'), init, ctx_out)

    def combine(f, y):
        b_, t_ = y.shape[:2]
        y = (y + d_skip.reshape(SSD_GROUPS, SSD_HPG)[..., None] * f['x']).reshape(b_, t_, D_INNER)
        y = (y * jax.nn.silu(f['z'])).reshape(b_, t_, SSD_GROUPS, D_INNER // SSD_GROUPS)
        y = rmsnorm(y, norm_g.reshape(SSD_GROUPS, D_INNER // SSD_GROUPS)).reshape(b_, t_, D_INNER)
        return y.astype(w_out.dtype) @ w_out

    return (combine(fc, yc) if ctx_out else None), combine(fl, yl)


def conv_ffn(h, w_up, conv_w, conv_b, w_down, rows):
    u = h @ w_up
    if rows is None:
        u = dwconv1d(u, conv_w[1], conv_b)
    else:
        u = dwconv2d_grid(u, conv_w, conv_b, rows)
    a, g = jnp.split(u, 2, axis=-1)
    return (jax.nn.silu(g) * a) @ w_down


def setup_inputs(seed: int = 0) -> dict:
    key = jax.random.key(seed)
    ks = list(jax.random.split(key, 40))
    f32 = jnp.float32

    def nrm(shape, scale):
        return scale * jax.random.normal(ks.pop(), shape, f32)

    def gain(shape):
        return 1.0 + 0.05 * jax.random.normal(ks.pop(), shape, f32)

    gate_base = jnp.concatenate([jnp.zeros((ML_HEADS,), f32), jnp.linspace(3.0, 6.0, ML_HEADS, dtype=f32)] * 2)
    dt0 = jnp.exp(jax.random.uniform(ks.pop(), (N_ODD, 2, SSD_HEADS), f32, math.log(1e-3), math.log(1e-1)))
    return {
        'x': nrm((BATCH, SEQ, D_MODEL), 1.0),
        'c': nrm((BATCH, D_MODEL), 1.0),
        'ctx': nrm((BATCH, CTX_LEN, D_MODEL), 1.0),
        'c_ctx': nrm((D_MODEL,), 1.0),
        'mod_w': nrm((DEPTH, D_MODEL, 6 * D_MODEL), 0.5 * D_MODEL ** -0.5),
        'mod_b': nrm((DEPTH, 6 * D_MODEL), 0.02),
        'norm_mix_g': gain((DEPTH, D_MODEL)),
        'norm_ffn_g': gain((DEPTH, D_MODEL)),
        'final_norm_g': gain((D_MODEL,)),
        'ffn_w_up': nrm((DEPTH, D_MODEL, 2 * D_FF), D_MODEL ** -0.5),
        'ffn_conv_w': nrm((DEPTH, FFN_CONV, FFN_CONV, 2 * D_FF), 1.0 / FFN_CONV),
        'ffn_conv_b': nrm((DEPTH, 2 * D_FF), 0.02),
        'ffn_w_down': nrm((DEPTH, D_FF, D_MODEL), D_FF ** -0.5),
        'even_w_in': nrm((N_EVEN, D_MODEL, EVEN_IN), D_MODEL ** -0.5),
        'gla_a1': nrm((N_EVEN, 2, D_MODEL, GLA_RANK), D_MODEL ** -0.5),
        'gla_a2': nrm((N_EVEN, 2, GLA_RANK, GLA_QK), GLA_RANK ** -0.5),
        'gla_ab': nrm((N_EVEN, 2, GLA_QK), 0.1),
        'ml_conv_w': nrm((N_EVEN, ML_CONV, 2 * ML_W), ML_CONV ** -0.5),
        'ml_conv_b': nrm((N_EVEN, 2 * ML_W), 0.02),
        'ml_gate_b': gate_base[None] + nrm((N_EVEN, 4 * ML_HEADS), 0.1),
        'gla_norm_g': gain((N_EVEN, GLA_V)),
        'ml_norm_g': gain((N_EVEN, ML_W)),
        'even_w_out': nrm((N_EVEN, GLA_V + ML_W, D_MODEL), (GLA_V + ML_W) ** -0.5),
        'ssd_w_in': nrm((N_ODD, D_MODEL, ODD_IN), D_MODEL ** -0.5),
        'ssd_conv_w': nrm((N_ODD, SSD_CONV, SSD_CONV_CH), SSD_CONV ** -0.5),
        'ssd_conv_b': nrm((N_ODD, SSD_CONV_CH), 0.02),
        'ssd_dt_bias': dt0 + jnp.log(-jnp.expm1(-dt0)),
        'ssd_a_log': jnp.log(jax.random.uniform(ks.pop(), (N_ODD, 2, SSD_HEADS), f32, 1.0, 16.0)),
        'ssd_d': gain((N_ODD, SSD_HEADS)),
        'ssd_norm_g': gain((N_ODD, D_INNER)),
        'ssd_w_out': nrm((N_ODD, D_INNER, D_MODEL), D_INNER ** -0.5),
    }


def reference(x, c, ctx, c_ctx, mod_w, mod_b, norm_mix_g, norm_ffn_g, final_norm_g,
              ffn_w_up, ffn_conv_w, ffn_conv_b, ffn_w_down,
              even_w_in, gla_a1, gla_a2, gla_ab, ml_conv_w, ml_conv_b, ml_gate_b,
              gla_norm_g, ml_norm_g, even_w_out,
              ssd_w_in, ssd_conv_w, ssd_conv_b, ssd_dt_bias, ssd_a_log, ssd_d, ssd_norm_g, ssd_w_out):
    rows = x.shape[1] // GRID_W
    xl, xc = x, ctx
    for layer in range(DEPTH):
        last = layer == DEPTH - 1
        mod_l = (jax.nn.silu(c) @ mod_w[layer] + mod_b[layer])[:, None, :]
        mod_c = (jax.nn.silu(c_ctx) @ mod_w[layer] + mod_b[layer])[None, None, :]
        sh1l, sc1l, g1l, sh2l, sc2l, g2l = jnp.split(mod_l, 6, axis=-1)
        sh1c, sc1c, g1c, sh2c, sc2c, g2c = jnp.split(mod_c, 6, axis=-1)
        hl = modulate(xl, norm_mix_g[layer], sh1l, sc1l)
        hc = modulate(xc, norm_mix_g[layer], sh1c, sc1c)
        if layer % 2 == 0:
            e = layer // 2
            yc, yl = even_mixer(hc, hl, even_w_in[e], gla_a1[e], gla_a2[e], gla_ab[e], ml_conv_w[e], ml_conv_b[e],
                                ml_gate_b[e], gla_norm_g[e], ml_norm_g[e], even_w_out[e], not last)
        else:
            o = layer // 2
            yc, yl = odd_mixer(hc, hl, ssd_w_in[o], ssd_conv_w[o], ssd_conv_b[o], ssd_dt_bias[o], ssd_a_log[o],
                               ssd_d[o], ssd_norm_g[o], ssd_w_out[o], not last)
        xl = xl + g1l * yl
        hl = modulate(xl, norm_ffn_g[layer], sh2l, sc2l)
        xl = xl + g2l * conv_ffn(hl, ffn_w_up[layer], ffn_conv_w[layer], ffn_conv_b[layer], ffn_w_down[layer], rows)
        if not last:
            xc = xc + g1c * yc
            hc = modulate(xc, norm_ffn_g[layer], sh2c, sc2c)
            xc = xc + g2c * conv_ffn(hc, ffn_w_up[layer], ffn_conv_w[layer], ffn_conv_b[layer], ffn_w_down[layer], None)
    return rmsnorm(xl, final_norm_g)
```

```cpp
#include <hip/hip_runtime.h>
#include <hip/hip_cooperative_groups.h>
#include <cstdio>
#include <cstdint>
namespace cg = cooperative_groups;

#define DEVI __device__ __forceinline__
#define LAS __attribute__((address_space(3)))
typedef unsigned short bf16_t;
typedef short bf16x8 __attribute__((ext_vector_type(8)));
typedef float f32x4 __attribute__((ext_vector_type(4)));

constexpr int NB = 16, TL = 2048, TC = 256, DM = 1024;
constexpr int MLAT = NB * TL;
constexpr int MCTX = NB * TC;
constexpr int MTOT = MLAT + MCTX;
constexpr int PLD = 3584;
constexpr int FLD = 48;
constexpr int N0IN = 3840, N1IN = 5376, DFF = 2816, NUP = 5632;
constexpr int SLABM = 18432, SLABL = 16384, SLABC = 2048;

constexpr size_t MiB = 1ull << 20;
constexpr size_t OFF_XC = 0;
constexpr size_t OFF_MOD = 16 * MiB;
constexpr size_t OFF_W = 17 * MiB;
constexpr size_t W0IN = 0, W0OUT = W0IN + (size_t)N0IN * 1024, UP0 = W0OUT + 1024 * 1024, DN0 = UP0 + (size_t)NUP * 1024,
                 W1IN = DN0 + (size_t)1024 * DFF, W1OUT = W1IN + (size_t)N1IN * 1024, UP1 = W1OUT + (size_t)1024 * 2048,
                 DN1 = UP1 + (size_t)NUP * 1024, WEND = DN1 + (size_t)1024 * DFF;
constexpr size_t OFF_H = 75 * MiB;
constexpr size_t OFF_BIG = 147 * MiB;
constexpr size_t OFF_P = OFF_BIG, OFF_F32 = OFF_BIG + 252 * MiB, OFF_R2 = OFF_BIG + 259 * MiB;
constexpr size_t OFF_U = OFF_BIG, OFF_ACT = OFF_BIG + 144 * MiB;
constexpr size_t OFF_XBC = OFF_BIG, OFF_Z = OFF_BIG + 108 * MiB, OFF_DT = OFF_BIG + 172 * MiB, OFF_XBCC = OFF_BIG + 177 * MiB, OFF_YF = OFF_BIG, OFF_YB = OFF_BIG + 285 * MiB;
constexpr size_t WS_NEED = OFF_BIG + 349 * MiB;
static_assert(WEND * 2 <= 58 * MiB, "weights region");

constexpr int LDS_BYTES = 144 * 1024;
constexpr int NPHASE = 36;

struct Params {
    const float* in[31];
    float* out;
    unsigned char* ws;
    int ph_lo, ph_hi;
};


#define GAS __attribute__((address_space(1)))
template <int OFF> DEVI const void* karg_ptr() { const GAS char* r; asm volatile("s_load_dwordx2 %0, %1, %2\n\ts_waitcnt lgkmcnt(0)" : "=s"(r) : "s"(__builtin_amdgcn_kernarg_segment_ptr()), "n"(OFF));
    return (const void*)r; }
#define INP(i) ((const float*)karg_ptr<(i) * 8>())
#define OUTP() ((float*)karg_ptr<31 * 8>())
#define WSP() ((unsigned char*)karg_ptr<32 * 8>())
template <int OFF> DEVI int karg_int() { int r; asm volatile("s_load_dword %0, %1, %2\n\ts_waitcnt lgkmcnt(0)" : "=s"(r) : "s"(__builtin_amdgcn_kernarg_segment_ptr()), "n"(OFF)); return r; }
#define PH_LO() karg_int<33 * 8>()
#define PH_HI() karg_int<33 * 8 + 4>()
DEVI int tid_l() { int t = threadIdx.x; asm volatile("" : "+v"(t)); return t; }
DEVI int bid_l() { int t = blockIdx.x; asm volatile("" : "+s"(t)); return t; }
DEVI bf16_t f2bf(float f) { unsigned u = __float_as_uint(f); u += 0x7FFFu + ((u >> 16) & 1u); return (bf16_t)(u >> 16); }
DEVI float bf2f(bf16_t b) { return __uint_as_float(((unsigned)b) << 16); }
typedef __bf16 bf16x2_t __attribute__((ext_vector_type(2)));
typedef float f32x2_t __attribute__((ext_vector_type(2)));
DEVI unsigned pack2(float a, float b) { const f32x2_t v = {a, b}; const bf16x2_t r = __builtin_convertvector(v, bf16x2_t); return __builtin_bit_cast(unsigned, r); }
DEVI uint2 pack4(f32x4 v) { uint2 r; r.x = pack2(v[0], v[1]); r.y = pack2(v[2], v[3]); return r; }
DEVI float silu_f(float v) { return v * __builtin_amdgcn_rcpf(1.f + __expf(-v)); }
DEVI float sigmoid_f(float v) { return __builtin_amdgcn_rcpf(1.f + __expf(-v)); }
DEVI float logsig_f(float x) { return fminf(x, 0.f) - __logf(1.f + __expf(-fabsf(x))); }
DEVI float softplus_f(float x) { return x > 20.f ? x : __logf(1.f + __expf(x)); }
DEVI float wave_sum(float v) {
#pragma unroll
    for (int o = 32; o >= 1; o >>= 1) v += __shfl_xor(v, o);
    return v;
}
DEVI bf16x8 ldsfrag(const bf16_t* base, int ld, int row, int k) { return *(const bf16x8*)(base + row * ld + k); }
DEVI f32x4 mfma16(bf16x8 a, bf16x8 b, f32x4 c) { return __builtin_amdgcn_mfma_f32_16x16x32_bf16(a, b, c, 0, 0, 0); }
DEVI void unpack8(bf16x8 v, float (&o)[8]) {
#pragma unroll
    for (int e = 0; e < 8; ++e) o[e] = bf2f((bf16_t)v[e]);
}
DEVI bf16x8 packf8(const float (&o)[8]) {
    typedef unsigned u32x4 __attribute__((ext_vector_type(4)));
    u32x4 r; r[0] = pack2(o[0], o[1]); r[1] = pack2(o[2], o[3]); r[2] = pack2(o[4], o[5]); r[3] = pack2(o[6], o[7]);
    return __builtin_bit_cast(bf16x8, r);
}
DEVI bf16_t f2bf1(float a) { return (bf16_t)(pack2(a, a) & 0xFFFFu); }
typedef short s16x4 __attribute__((ext_vector_type(4)));
template <int LD> DEVI bf16x8 tr_frag(const bf16_t* base, int s0, int c0, int l15, int lq) {
#ifdef TR_EMUL
    bf16x8 r;
#pragma unroll
    for (int e = 0; e < 8; ++e) r[e] = (short)base[(s0 + lq * 8 + e) * LD + c0 + l15];
    return r;
#else
    const bf16_t* a = base + (s0 + lq * 8 + (l15 >> 2)) * LD + c0 + 4 * (l15 & 3);
    const s16x4 lo = __builtin_amdgcn_ds_read_tr16_b64_v4i16((LAS s16x4*)a);
    const s16x4 hi = __builtin_amdgcn_ds_read_tr16_b64_v4i16((LAS s16x4*)(a + 4 * LD));
    return __builtin_shufflevector(lo, hi, 0, 1, 2, 3, 4, 5, 6, 7);
#endif
}
template <class WT> DEVI void conv2x8w(bf16x8 r0, bf16x8 r1, bf16x8 r2, bf16x8 r3, bool v0, bool v3, const WT& cw, bf16x8& o0, bf16x8& o1) {
    const bf16x8 zz = {0, 0, 0, 0, 0, 0, 0, 0};
    if (!v0) r0 = zz;
    if (!v3) r3 = zz;
    float a[8], b[8];
#pragma unroll
    for (int e = 0; e < 8; ++e) { const f32x4 w = cw[e];
        const float x0 = bf2f((bf16_t)r0[e]), x1 = bf2f((bf16_t)r1[e]), x2 = bf2f((bf16_t)r2[e]), x3 = bf2f((bf16_t)r3[e]);
        a[e] = silu_f(w[0] * x0 + w[1] * x1 + w[2] * x2 + w[3]); b[e] = silu_f(w[0] * x1 + w[1] * x2 + w[2] * x3 + w[3]); }
    o0 = packf8(a); o1 = packf8(b);
}
DEVI void conv2x8(bf16x8 r0, bf16x8 r1, bf16x8 r2, bf16x8 r3, bool v0, bool v3, const f32x4* cw, bf16x8& o0, bf16x8& o1) {
    const bf16x8 zz = {0, 0, 0, 0, 0, 0, 0, 0};
    if (!v0) r0 = zz;
    if (!v3) r3 = zz;
    float a[8], b[8];
#pragma unroll
    for (int e = 0; e < 8; ++e) { const f32x4 w = cw[e];
        const float x0 = bf2f((bf16_t)r0[e]), x1 = bf2f((bf16_t)r1[e]), x2 = bf2f((bf16_t)r2[e]), x3 = bf2f((bf16_t)r3[e]);
        a[e] = silu_f(w[0] * x0 + w[1] * x1 + w[2] * x2 + w[3]); b[e] = silu_f(w[0] * x1 + w[1] * x2 + w[2] * x3 + w[3]); }
    o0 = packf8(a); o1 = packf8(b);
}

namespace pg8 {
constexpr int BM = 256, BK = 64, HALF = 128, HTB = HALF * BK * 2, STAGE_BYTES = 8 * HTB, NXCD = 8, WGM = 8;
DEVI int lds_byte(int r, int c) { const int st = (r >> 4) * 2 + (c >> 5), rr = r & 15, cc = c & 31, ob = rr * 64 + cc * 2; return st * 1024 + (ob ^ (((ob >> 9) & 1) << 5)); }
DEVI void stage_rc(int b, int& R, int& C) { const int st = b / 1024, sb = b % 1024, swz = sb ^ (((sb >> 9) & 1) << 5); R = (st >> 1) * 16 + swz / 64; C = (st & 1) * 32 + (swz % 64) / 2; }
struct Unit { int pm, pn; };
struct Gemm { const bf16_t* A; const bf16_t* Bt; int M, N, K; int split, off0, off1; };
struct StaticOrder {
    int nM, nN, nwg, G, c;
    DEVI void init(int M, int N, int G_, int c_) { nM = M / BM; nN = N / BM; nwg = nM * nN; G = G_; c = c_; }
    DEVI bool next(int i, Unit& u) const {
        const long L = (long)i * G + c; if (L >= nwg) return false;
        int wgid = (int)L; { const int q = nwg / NXCD, r = nwg % NXCD, xcd = wgid % NXCD, off = wgid / NXCD; wgid = (xcd < r ? xcd * (q + 1) : r * (q + 1) + (xcd - r) * q) + off; }
        const int nig = WGM * nN, gid = wgid / nig, fm = gid * WGM, gsz = (nM - fm) < WGM ? (nM - fm) : WGM;
        u.pm = fm + ((wgid % nig) % gsz); u.pn = (wgid % nig) / gsz; return true;
    }
};

template <class Epi>
DEVI void gemm_phase(LAS unsigned char* lds, const Gemm g, const StaticOrder& S, const Epi& E) {
    const int tid = tid_l(), wid = __builtin_amdgcn_readfirstlane(tid >> 6), lane = tid & 63, wr = wid >> 2, wc = wid & 3, fr = lane & 15, fq = lane >> 4;
    const int K = g.K, nt = K / BK;
    unsigned voffA[2];
#pragma unroll
    for (int i = 0; i < 2; ++i) { int R, C; stage_rc(tid * 16 + i * 8192, R, C); voffA[i] = (unsigned)(R * K + C) * 2u; }
    const size_t kstep = (size_t)(BK * 2);
    const size_t hstep = (size_t)HALF * K * 2;
    const size_t tstep = 2 * hstep;
    const unsigned ldsw = (unsigned)wid * 1024u;
    const int aoff = lds_byte(wr * 64 + fr, fq * 8), boff = lds_byte(wc * 32 + fr, fq * 8);
#define PG8_SA(b, h) (((b) * 2 + (h)) * HTB)
#define PG8_SB(b, h) ((4 + (b) * 2 + (h)) * HTB)
#define PG8_STAGE(bufoff, gbase) do { _Pragma("unroll") for (int _i = 0; _i < 2; ++_i) \
        __builtin_amdgcn_global_load_lds((const unsigned*)((const char*)(gbase) + voffA[_i]), (LAS unsigned*)(lds + (bufoff) + ldsw + _i * 8192), 16, 0, 0); } while (0)
#define PG8_LDA(dst, b, h) do { _Pragma("unroll") for (int m = 0; m < 4; ++m) _Pragma("unroll") for (int k = 0; k < 2; ++k) dst[m][k] = *(const LAS bf16x8*)(lds + PG8_SA(b, h) + aoff + m * 2048 + k * 1024); } while (0)
#define PG8_LDB(dst, b, h) do { _Pragma("unroll") for (int n = 0; n < 2; ++n) _Pragma("unroll") for (int k = 0; k < 2; ++k) dst[n][k] = *(const LAS bf16x8*)(lds + PG8_SB(b, h) + boff + n * 2048 + k * 1024); } while (0)
#define PG8_MMA(ai, bj, At, Bt) do { __builtin_amdgcn_s_setprio(1); _Pragma("unroll") for (int m = 0; m < 4; ++m) _Pragma("unroll") for (int n = 0; n < 2; ++n) _Pragma("unroll") for (int k = 0; k < 2; ++k) \
        acc[ai][bj][m][n] = __builtin_amdgcn_mfma_f32_16x16x32_bf16(Bt[n][k], At[m][k], acc[ai][bj][m][n], 0, 0, 0); __builtin_amdgcn_s_setprio(0); } while (0)
#define PG8_WAIT_V(n) asm volatile("s_waitcnt vmcnt(" #n ")" ::: "memory")
#define PG8_WAIT_L(n) asm volatile("s_waitcnt lgkmcnt(" #n ")" ::: "memory")
#define PG8_BAR __builtin_amdgcn_s_barrier()
#define PG8_SCHED __builtin_amdgcn_sched_barrier(0)
#define PG8_PHYS(pm) ((pm) < g.split ? (pm) + g.off0 : (pm) - g.split + g.off1)
    Unit cur, nxt; int ui = 0;
    if (!S.next(0, cur)) return;
    f32x4 acc[2][2][4][2];
#pragma unroll
    for (int a = 0; a < 2; ++a)
#pragma unroll
        for (int b = 0; b < 2; ++b)
#pragma unroll
            for (int m = 0; m < 4; ++m)
#pragma unroll
                for (int n = 0; n < 2; ++n) acc[a][b][m][n] = (f32x4){0.f, 0.f, 0.f, 0.f};
    bf16x8 At[4][2], B0[2][2], B1[2][2];
    const char* cA = (const char*)g.A + (size_t)PG8_PHYS(cur.pm) * tstep; const char* cB = (const char*)g.Bt + (size_t)cur.pn * tstep;
    PG8_STAGE(PG8_SB(0, 0), cB); PG8_STAGE(PG8_SA(0, 0), cA); PG8_STAGE(PG8_SB(0, 1), cB + hstep); PG8_STAGE(PG8_SA(0, 1), cA + hstep);
    if (wr == 1) PG8_BAR;
    PG8_WAIT_V(4); PG8_BAR;
    PG8_STAGE(PG8_SB(1, 0), cB + kstep); PG8_STAGE(PG8_SA(1, 0), cA + kstep); PG8_STAGE(PG8_SB(1, 1), cB + hstep + kstep);
    PG8_WAIT_V(6); PG8_BAR;
    for (;;) {
        const bool has_next = S.next(ui + 1, nxt);
        const char* nA = has_next ? (const char*)g.A + (size_t)PG8_PHYS(nxt.pm) * tstep : cA; const char* nB = has_next ? (const char*)g.Bt + (size_t)nxt.pn * tstep : cB;
        for (int t = 0; t < nt; t += 2) {
            const bool last = (t == nt - 2);
            const char* a1 = cA + (size_t)(t + 1) * kstep;
            const char* a2 = last ? nA : cA + (size_t)(t + 2) * kstep; const char* b2 = last ? nB : cB + (size_t)(t + 2) * kstep;
            const char* a3 = a2 + kstep; const char* b3 = b2 + kstep;
            PG8_LDB(B0, 0, 0); PG8_SCHED; PG8_LDA(At, 0, 0); PG8_STAGE(PG8_SA(1, 1), a1 + hstep);
            PG8_WAIT_L(8); PG8_BAR; PG8_WAIT_L(0); PG8_MMA(0, 0, At, B0); PG8_BAR; PG8_SCHED;
            PG8_LDB(B1, 0, 1); PG8_STAGE(PG8_SB(0, 0), b2);
            PG8_BAR; PG8_WAIT_L(0); PG8_MMA(0, 1, At, B1); PG8_BAR;
            PG8_LDA(At, 0, 1); PG8_STAGE(PG8_SA(0, 0), a2);
            PG8_BAR; PG8_WAIT_L(0); PG8_MMA(1, 0, At, B0); PG8_BAR; PG8_SCHED;
            PG8_STAGE(PG8_SB(0, 1), b2 + hstep);
            PG8_WAIT_V(6); PG8_BAR; PG8_MMA(1, 1, At, B1); PG8_BAR;
            PG8_LDB(B0, 1, 0); PG8_SCHED; PG8_LDA(At, 1, 0); PG8_STAGE(PG8_SA(0, 1), a2 + hstep);
            PG8_WAIT_L(8); PG8_BAR; PG8_WAIT_L(0); PG8_MMA(0, 0, At, B0); PG8_BAR; PG8_SCHED;
            PG8_LDB(B1, 1, 1); PG8_STAGE(PG8_SB(1, 0), b3);
            PG8_BAR; PG8_WAIT_L(0); PG8_MMA(0, 1, At, B1); PG8_BAR;
            PG8_LDA(At, 1, 1); PG8_STAGE(PG8_SA(1, 0), a3);
            PG8_BAR; PG8_WAIT_L(0); PG8_MMA(1, 0, At, B0); PG8_BAR; PG8_SCHED;
            PG8_STAGE(PG8_SB(1, 1), b3 + hstep);
            PG8_WAIT_V(6); PG8_BAR; PG8_MMA(1, 1, At, B1); PG8_BAR;
        }
        { int tid2 = tid_l(); const int wid2 = tid2 >> 6, lane2 = tid2 & 63; E(acc, cur, wid2 >> 2, wid2 & 3, lane2 & 15, lane2 >> 4); }
        if (!has_next) break;
#pragma unroll
        for (int a = 0; a < 2; ++a)
#pragma unroll
            for (int b = 0; b < 2; ++b)
#pragma unroll
                for (int m = 0; m < 4; ++m)
#pragma unroll
                    for (int n = 0; n < 2; ++n) acc[a][b][m][n] = (f32x4){0.f, 0.f, 0.f, 0.f};
        cur = nxt; cA = nA; cB = nB; ++ui;
    }
    PG8_WAIT_V(0);
    if (wr == 0) PG8_BAR;
    PG8_BAR;
#undef PG8_SA
#undef PG8_SB
#undef PG8_STAGE
#undef PG8_LDA
#undef PG8_LDB
#undef PG8_MMA
#undef PG8_WAIT_V
#undef PG8_WAIT_L
#undef PG8_BAR
#undef PG8_SCHED
#undef PG8_PHYS
}
}
using pg8::Unit;

struct EpiBf16 {
    bf16_t* O; int ldc;
    DEVI void operator()(const f32x4 (&acc)[2][2][4][2], const Unit& u, int wr, int wc, int fr, int fq) const {
        const int row0 = u.pm * 256 + wr * 64 + fr, col0 = u.pn * 256 + wc * 32 + 8 * fq;
#pragma unroll
        for (int ai = 0; ai < 2; ++ai)
#pragma unroll
            for (int m = 0; m < 4; ++m) { bf16_t* rowp = O + (size_t)(row0 + ai * 128 + m * 16) * ldc + col0;
#pragma unroll
                for (int bj = 0; bj < 2; ++bj) { const uint2 a = pack4(acc[ai][bj][m][0]), b = pack4(acc[ai][bj][m][1]);
                    *(uint4*)(rowp + bj * 128) = make_uint4(a.x, a.y, b.x, b.y); } }
    }
};
struct EpiInL0 {
    bf16_t* P; float* F; bf16_t* R2raw;
    DEVI void operator()(const f32x4 (&acc)[2][2][4][2], const Unit& u, int wr, int wc, int fr, int fq) const {
        const int row0 = u.pm * 256 + wr * 64 + fr;
        if (u.pn >= 6 && u.pn < 10) { EpiBf16 e{R2raw, 1024}; Unit v = u; v.pn -= 6; e(acc, v, wr, wc, fr, fq); return; }
        if (u.pn < 14) { EpiBf16 e{P, PLD}; e(acc, u, wr, wc, fr, fq); return; }
        const int c0 = wc * 32 + 4 * fq;
#pragma unroll
        for (int ai = 0; ai < 2; ++ai)
#pragma unroll
            for (int m = 0; m < 4; ++m) { float* rowp = F + (size_t)(row0 + ai * 128 + m * 16) * FLD;
#pragma unroll
                for (int n = 0; n < 2; ++n) { const int c = c0 + n * 16; if (c < 48) *(f32x4*)(rowp + c) = acc[ai][0][m][n]; } }
    }
};
struct EpiInL1 {
    bf16_t* X; bf16_t* Z; float* DT;
    DEVI void operator()(const f32x4 (&acc)[2][2][4][2], const Unit& u, int wr, int wc, int fr, int fq) const {
        if (u.pn < 12) { EpiBf16 e{X, 3072}; e(acc, u, wr, wc, fr, fq); return; }
        if (u.pn < 20) { if (u.pm < 64) { EpiBf16 e{Z, 2048}; Unit v = u; v.pn -= 12; e(acc, v, wr, wc, fr, fq); } return; }
        const int row0 = u.pm * 256 + wr * 64 + fr, c0 = wc * 32 + 4 * fq;
#pragma unroll
        for (int ai = 0; ai < 2; ++ai)
#pragma unroll
            for (int m = 0; m < 4; ++m) { float* rowp = DT + (size_t)(row0 + ai * 128 + m * 16) * 64;
#pragma unroll
                for (int n = 0; n < 2; ++n) { const int c = c0 + n * 16; if (c < 64) *(f32x4*)(rowp + c) = acc[ai][0][m][n]; } }
    }
};
struct EpiResid {
    float* XL; float* XC; const float* mod; int goff; int rowbase;
    DEVI void operator()(const f32x4 (&acc)[2][2][4][2], const Unit& u, int wr, int wc, int fr, int fq) const {
        const int grow_t = __builtin_amdgcn_readfirstlane(rowbase + u.pm * 256);
        const bool isc = grow_t >= MLAT;
        const int bidx = isc ? 16 : (grow_t >> 11);
        float* X = isc ? XC + (size_t)(grow_t - MLAT) * DM : XL + (size_t)grow_t * DM;
        const float* gate = mod + (size_t)bidx * 6144 + goff + u.pn * 256;
        X += u.pn * 256;
        const unsigned r0 = wr * 64 + fr, c0 = wc * 32 + 8 * fq;
        f32x4 gv[2][2];
#pragma unroll
        for (int bj = 0; bj < 2; ++bj)
#pragma unroll
            for (int n = 0; n < 2; ++n) gv[bj][n] = *(const f32x4*)(gate + c0 + bj * 128 + n * 4);
#pragma unroll
        for (int ai = 0; ai < 2; ++ai) {
            f32x4 rv[4][2][2];
#pragma unroll
            for (int m = 0; m < 4; ++m) { const unsigned ro = (r0 + ai * 128 + m * 16) * DM + c0;
#pragma unroll
                for (int bj = 0; bj < 2; ++bj)
#pragma unroll
                    for (int n = 0; n < 2; ++n) rv[m][bj][n] = *(const f32x4*)(X + ro + bj * 128 + n * 4); }
#pragma unroll
            for (int m = 0; m < 4; ++m) { const unsigned ro = (r0 + ai * 128 + m * 16) * DM + c0;
#pragma unroll
                for (int bj = 0; bj < 2; ++bj)
#pragma unroll
                    for (int n = 0; n < 2; ++n) *(f32x4*)(X + ro + bj * 128 + n * 4) = rv[m][bj][n] + gv[bj][n] * acc[ai][bj][m][n]; }
            __builtin_amdgcn_sched_barrier(0); }
    }
};

template <class Epi>
DEVI void run_gemm(unsigned char* shm, const bf16_t* A, const bf16_t* Bt, int M, int N, int K, const Epi& E, int split = 1 << 30, int off0 = 0, int off1 = 0, int nblk = 0) {
    pg8::Gemm g{A, Bt, M, N, K, split, off0, off1};
    pg8::StaticOrder S; S.init(M, N, nblk ? nblk : (int)gridDim.x, (int)bid_l());
    pg8::gemm_phase<Epi>((LAS unsigned char*)shm, g, S, E);
}

DEVI int perm32(int rho) { const int n = rho >> 4, i = rho & 15; return 8 * (i >> 2) + 4 * n + (i & 3); }
DEVI void wsrc_col(const Params& p, int m, int n, const float*& ptr, long& stride) {
    ptr = nullptr; stride = 0;
    if ((m == 0 && n < 3584) || m == 2 || m == 6 || (m == 4 && n < 5120) || m == 1 || m == 3 || m == 5 || m == 7) n = (n & ~31) + perm32(n & 31);
    switch (m) {
    case 0: if (n < 3600) { ptr = INP(13) + n; stride = 3600; } else if (n < 3632) { const int d = (n - 3600) >> 4, r = (n - 3600) & 15; ptr = INP(14) + d * 16384 + r; stride = 16; } break;
    case 1: ptr = INP(22) + n; stride = 1024; break;
    case 2: case 6: { const int g = n < 2048 ? 0 : (n < 4096 ? 1 : 2); const int base = g * 2048, w = g == 2 ? 768 : 1024, j0 = g * 1024, o = n - base;
        const int col = o < w ? j0 + o : 2816 + j0 + (o - w); ptr = INP(9) + (size_t)(m == 6 ? 1 : 0) * 1024 * NUP + col; stride = NUP; } break;
    case 3: case 7: ptr = INP(12) + (size_t)(m == 7 ? 1 : 0) * DFF * 1024 + n; stride = 1024; break;
    case 4: if (n < 5184) { const int col = n < 3072 ? 2048 + n : (n < 5120 ? n - 3072 : n); ptr = INP(23) + col; stride = 5184; } break;
    case 5: ptr = INP(30) + n; stride = 1024; break;
    }
}
DEVI void phase_prep(const Params& p, unsigned char* shm) {
    bf16_t* Wb = (bf16_t*)(WSP() + OFF_W);
    float* tile = (float*)shm;
    const int tid = tid_l();
    const int nbk[8] = {60 * 4, 16 * 4, 88 * 4, 16 * 11, 84 * 4, 16 * 8, 88 * 4, 16 * 11};
    const int kb_[8] = {4, 4, 4, 11, 4, 8, 4, 11};
    const size_t woff[8] = {W0IN, W0OUT, UP0, DN0, W1IN, W1OUT, UP1, DN1};
    int total = 0;
#pragma unroll
    for (int i = 0; i < 8; ++i) total += nbk[i];
    for (int u = bid_l(); u < total; u += gridDim.x) {
        int m = 0, r = u;
#pragma unroll
        for (int i = 0; i < 8; ++i) { if (m == i && r >= nbk[i]) { r -= nbk[i]; m = i + 1; } }
        int kbn = 4; size_t wo = 0;
#pragma unroll
        for (int i = 0; i < 8; ++i) if (m == i) { kbn = kb_[i]; wo = woff[i]; }
        const int nblk = r / kbn, kblk = r % kbn, K = kbn * 256;
        const int n0 = nblk * 64, k0 = kblk * 256;
        const float* cp; long cs; wsrc_col(p, m, n0 + (tid & 63), cp, cs);
        __syncthreads();
        float ld_[32];
#pragma unroll
        for (int i = 0; i < 32; ++i) { const int k = i * 8 + (tid >> 6); ld_[i] = cp ? cp[(size_t)(k0 + k) * cs] : 0.f; }
#pragma unroll
        for (int i = 0; i < 32; ++i) { const int k = i * 8 + (tid >> 6); tile[k * 65 + (tid & 63)] = ld_[i]; }
        __syncthreads();
#pragma unroll
        for (int q = 0; q < 4; ++q) { const int n = tid >> 3, kq = q * 64 + (tid & 7) * 8; float v[8];
#pragma unroll
          for (int e = 0; e < 8; ++e) v[e] = tile[(kq + e) * 65 + n];
          *(bf16x8*)(Wb + wo + (size_t)(n0 + n) * K + k0 + kq) = packf8(v); }
    }
    __syncthreads();
    float* sc = (float*)shm;
    float* red = sc + 17 * 1024;
    const int nmu = 2 * 192;
    if ((int)bid_l() < nmu) {
        for (int i = tid; i < 17 * 1024; i += 512) { const int v = i >> 10, k = i & 1023; const float c = v < 16 ? INP(1)[v * 1024 + k] : INP(3)[k]; sc[i] = silu_f(c); }
        __syncthreads();
        float* MOD = (float*)(WSP() + OFF_MOD);
        for (int u = bid_l(); u < nmu; u += gridDim.x) {
            const int layer = u / 192, cb = (u % 192) * 32, col = tid & 31, kg = tid >> 5;
            const float* w = INP(4) + (size_t)layer * 1024 * 6144 + cb + col;
            float a[17];
#pragma unroll
            for (int v = 0; v < 17; ++v) a[v] = 0.f;
            for (int k0 = kg * 64; k0 < kg * 64 + 64; k0 += 16) { float wv[16];
#pragma unroll
                for (int q = 0; q < 16; ++q) wv[q] = w[(size_t)(k0 + q) * 6144];
#pragma unroll
                for (int q = 0; q < 16; ++q) {
#pragma unroll
                    for (int v = 0; v < 17; ++v) a[v] += sc[v * 1024 + k0 + q] * wv[q]; } }
#pragma unroll
            for (int v = 0; v < 17; ++v) red[(kg * 17 + v) * 32 + col] = a[v];
            __syncthreads();
            for (int i = tid; i < 17 * 32; i += 512) { const int v = i >> 5, c = i & 31; float s = INP(5)[layer * 6144 + cb + c];
#pragma unroll
                for (int q = 0; q < 16; ++q) s += red[(q * 17 + v) * 32 + c];
                MOD[((size_t)layer * 17 + v) * 6144 + cb + c] = s; }
            __syncthreads();
        }
    }
}

DEVI void phase_modulate(const Params& p, const float* srcL, const float* srcC, int nrows, const float* g, int layer, int soff, float* cpL = nullptr, float* cpC = nullptr, int rbeg = 0, int b0 = 0) {
    const int tid_ = tid_l(); const int wid = tid_ >> 6, lane = tid_ & 63;
    bf16_t* H = (bf16_t*)(WSP() + OFF_H);
    const float* MOD = (const float*)(WSP() + OFF_MOD) + (size_t)layer * 17 * 6144;
    if ((int)bid_l() < b0) return;
    const int nw = ((int)gridDim.x - b0) * 8, gw = ((int)bid_l() - b0) * 8 + wid;
    const int wpb = nw / NB, bb = gw / wpb, jj = gw % wpb;
    const int itl = (rbeg < MLAT) ? (TL + wpb - 1) / wpb : 0;
    const int cbeg = max(rbeg, MLAT), nctx = max(nrows - cbeg, 0), itc = (nctx + nw - 1) / nw;
    auto rowat = [&](int it) -> int { if (it < itl) { const int t = jj + wpb * it; return t < TL ? bb * TL + t : -1; }
        const int r = cbeg + gw + nw * (it - itl); return (it < itl + itc && r < nrows) ? r : -1; };
    f32x4 v[4], nv[4], gs[4], sh[4];
#pragma unroll
    for (int i = 0; i < 4; ++i) { gs[i] = (f32x4){0.f, 0.f, 0.f, 0.f}; sh[i] = gs[i]; nv[i] = gs[i]; v[i] = gs[i]; }
    int cur_b = -1;
    auto loadrow = [&](int r, f32x4 (&d)[4]) { const bool isc = r >= MLAT; const float* src = isc ? srcC + (size_t)(r - MLAT) * DM : srcL + (size_t)r * DM;
#pragma unroll
        for (int i = 0; i < 4; ++i) d[i] = *(const f32x4*)(src + i * 256 + lane * 4); };
    const int nit = itl + itc;
    int row = nit > 0 ? rowat(0) : -1;
    if (row >= 0) loadrow(row, v);
    for (int it = 0; it < nit; ++it) {
        const int nrow = (it + 1 < nit) ? rowat(it + 1) : -1;
        if (nrow >= 0) loadrow(nrow, nv);
        if (row >= 0) {
            const bool isc = row >= MLAT;
            const int b = isc ? 16 : (row >> 11);
            if (b != cur_b) { cur_b = b; const float* md = MOD + (size_t)b * 6144 + soff;
#pragma unroll
                for (int i = 0; i < 4; ++i) { const int c = i * 256 + lane * 4; const f32x4 gg = *(const f32x4*)(g + c), sc = *(const f32x4*)(md + 1024 + c); sh[i] = *(const f32x4*)(md + c); gs[i] = gg * (sc + 1.f); } }
            float ss = 0.f;
#pragma unroll
            for (int i = 0; i < 4; ++i) ss += v[i][0] * v[i][0] + v[i][1] * v[i][1] + v[i][2] * v[i][2] + v[i][3] * v[i][3];
            ss = wave_sum(ss);
            if (cpL) { float* cp = isc ? cpC + (size_t)(row - MLAT) * DM : cpL + (size_t)row * DM;
#pragma unroll
                for (int i = 0; i < 4; ++i) *(f32x4*)(cp + i * 256 + lane * 4) = v[i]; }
            const float rstd = rsqrtf(ss * (1.f / 1024.f) + 1e-6f);
#pragma unroll
            for (int i = 0; i < 4; ++i) { const int c = i * 256 + lane * 4;
                *(uint2*)(H + (size_t)row * DM + c) = pack4(v[i] * rstd * gs[i] + sh[i]); }
        }
#pragma unroll
        for (int i = 0; i < 4; ++i) v[i] = nv[i];
        row = nrow;
    }
}
DEVI void phase_final_norm(const Params& p) {
    const int tid_ = tid_l(); const int wid = tid_ >> 6, lane = tid_ & 63;
    const float* g = INP(8);
    float* X = OUTP();
    const int stride = gridDim.x * 8;
    int row = bid_l() * 8 + wid;
    f32x4 v[4], nv[4], gg[4];
#pragma unroll
    for (int i = 0; i < 4; ++i) gg[i] = *(const f32x4*)(g + i * 256 + lane * 4);
    if (row < MLAT) {
#pragma unroll
        for (int i = 0; i < 4; ++i) v[i] = *(const f32x4*)(X + (size_t)row * DM + i * 256 + lane * 4); }
    for (; row < MLAT; row += stride) {
        if (row + stride < MLAT) {
#pragma unroll
            for (int i = 0; i < 4; ++i) nv[i] = *(const f32x4*)(X + (size_t)(row + stride) * DM + i * 256 + lane * 4); }
        float ss = 0.f;
#pragma unroll
        for (int i = 0; i < 4; ++i) ss += v[i][0] * v[i][0] + v[i][1] * v[i][1] + v[i][2] * v[i][2] + v[i][3] * v[i][3];
        ss = wave_sum(ss);
        const float rstd = rsqrtf(ss * (1.f / 1024.f) + 1e-6f);
#pragma unroll
        for (int i = 0; i < 4; ++i) *(f32x4*)(X + (size_t)row * DM + i * 256 + lane * 4) = v[i] * rstd * gg[i];
#pragma unroll
        for (int i = 0; i < 4; ++i) v[i] = nv[i];
    }
}

template <int N>
DEVI void conv_silu(const bf16_t* src, int ld, int pos0, int seqlen, float w0, float w1, float w2, float bias, float (&out)[N]) {
    const bool has_prev = pos0 >= 1, has_next = pos0 + N < seqlen;
    bf16_t raw[N + 2];
    raw[0] = src[has_prev ? -(long)ld : 0];
#pragma unroll
    for (int i = 0; i < N; ++i) raw[i + 1] = src[(size_t)i * ld];
    raw[N + 1] = src[(size_t)(has_next ? N : N - 1) * ld];
    float prev = has_prev ? bf2f(raw[0]) : 0.f;
    float cur = bf2f(raw[1]);
#pragma unroll
    for (int i = 0; i < N; ++i) {
        const float nxt = (i + 1 < N) ? bf2f(raw[i + 2]) : (has_next ? bf2f(raw[N + 1]) : 0.f);
        out[i] = silu_f(w0 * prev + w1 * cur + w2 * nxt + bias);
        prev = cur; cur = nxt;
    }
}
template <int N>
DEVI void store_row_t(bf16_t* dst, const float (&v)[N]) {
#pragma unroll
    for (int q = 0; q < N / 8; ++q) { bf16x8 r;
#pragma unroll
        for (int e = 0; e < 8; ++e) r[e] = (short)f2bf(v[q * 8 + e]);
        *(bf16x8*)(dst + q * 8) = r; }
}
DEVI void chain_chunk(int b, int dir, int step, int& row0, int& pos0, int& seqlen, bool& is_ctx) {
    if (step < 4) { const int c = dir ? 3 - step : step; is_ctx = true; pos0 = c * 64; seqlen = TC; row0 = MLAT + b * TC + pos0; }
    else { const int c = dir ? 31 - (step - 4) : (step - 4); is_ctx = false; pos0 = c * 64; seqlen = TL; row0 = b * TL + pos0; }
}

DEVI void gla_chain(const Params& p, int b, int h, int dir, unsigned char* shm) {
    bf16_t* sQ = (bf16_t*)shm;
    bf16_t* sK = sQ + 64 * 72;
    bf16_t* sKe = sK + 64 * 72;
    bf16_t* sVt = sKe + 64 * 72;
    bf16_t* sAt = sVt + 128 * 72;
    bf16_t* sSt = sAt + 64 * 72;
    float* sSeg = (float*)(sSt + 128 * 72);
    float* sR = sSeg + 8 * 64;
    float* sDec = sR + 64 * 16;
    const int tid = tid_l(), wid = tid >> 6, lane = tid & 63, l15 = lane & 15, lq = lane >> 4;
    const bf16_t* P = (const bf16_t*)(WSP() + OFF_P);
    const float* F = (const float*)(WSP() + OFF_F32);
    bf16_t* R1 = (bf16_t*)(WSP() + OFF_H);
    const int k = lane, tg = wid;
    float a2v[16];
#pragma unroll
    for (int r = 0; r < 16; ++r) a2v[r] = INP(15)[(dir * 16 + r) * 256 + h * 64 + k];
    const float abv = INP(16)[dir * 256 + h * 64 + k];
    f32x4 S[4];
#pragma unroll
    for (int i = 0; i < 4; ++i) S[i] = (f32x4){0.f, 0.f, 0.f, 0.f};
    __syncthreads();
    for (int i = tid; i < 128 * 72 / 2; i += 512) ((unsigned*)sSt)[i] = 0u;
    bf16_t qraw[8], kraw[8], vraw[16]; float2 rr;
    auto issue = [&](int step) {
        int row0, pos0, seqlen; bool ic; chain_chunk(b, dir, step, row0, pos0, seqlen, ic);
        { const int idx = tid * 2, t = idx >> 4, r = idx & 15; rr = *(const float2*)(F + (size_t)(row0 + t) * FLD + 16 + dir * 16 + r); }
#pragma unroll
        for (int j = 0; j < 8; ++j) { const int t = tg * 8 + j; qraw[j] = P[(size_t)(row0 + t) * PLD + h * 64 + k]; kraw[j] = P[(size_t)(row0 + t) * PLD + 256 + h * 64 + k]; }
        { const int v = tid & 127, tq = tid >> 7;
#pragma unroll
          for (int j = 0; j < 16; ++j) vraw[j] = P[(size_t)(row0 + tq * 16 + j) * PLD + 512 + h * 128 + v]; } };
    issue(0);
    { const int idx = tid * 2, t = idx >> 4, r = idx & 15; sR[t * 16 + r] = rr.x; sR[t * 16 + r + 1] = rr.y; }
    __syncthreads();
    for (int step = 0; step < 36; ++step) {
        int row0, pos0, seqlen; bool is_ctx; chain_chunk(b, dir, step, row0, pos0, seqlen, is_ctx);
        float cl[8];
        {
            float la[8];
#pragma unroll
            for (int j = 0; j < 8; ++j) { const int t = tg * 8 + j; float x = abv;
#pragma unroll
                for (int r = 0; r < 16; ++r) x += sR[t * 16 + r] * a2v[r];
                la[j] = logsig_f(x) * (1.f / 16.f); }
            if (!dir) { float s = 0.f;
#pragma unroll
                for (int j = 0; j < 8; ++j) { s += la[j]; cl[j] = s; }
                sSeg[tg * 64 + k] = s; }
            else { float s = 0.f;
#pragma unroll
                for (int j = 7; j >= 0; --j) { s += la[j]; cl[j] = s; }
                sSeg[tg * 64 + k] = s; }
        }
        __syncthreads();
        {
            float off = 0.f, tot = 0.f;
#pragma unroll
            for (int q = 0; q < 8; ++q) { const float sv = sSeg[q * 64 + k]; tot += sv; if (dir ? (q > tg) : (q < tg)) off += sv; }
            if (tg == 0) sDec[k] = __expf(tot);
            float ke[8];
#pragma unroll
            for (int j = 0; j < 8; ++j) { const int t = tg * 8 + j; const float cum = cl[j] + off;
                const float qv = bf2f(qraw[j]), kv = bf2f(kraw[j]);
                sQ[t * 72 + k] = f2bf1(qv * __expf(cum) * 0.125f);
                sK[t * 72 + k] = f2bf1(kv * __expf(-cum));
                ke[j] = kv * __expf(tot - cum); }
            store_row_t<8>(sKe + k * 72 + tg * 8, ke);
            const int v = tid & 127, tq = tid >> 7; float vv[16];
#pragma unroll
            for (int j = 0; j < 16; ++j) vv[j] = bf2f(vraw[j]);
            store_row_t<16>(sVt + v * 72 + tq * 16, vv);
            if (step + 1 < 36) issue(step + 1);
        }
        __syncthreads();
        { const int tm = wid >> 1;
#pragma unroll
          for (int q = 0; q < 2; ++q) { const int tn = (wid & 1) * 2 + q; f32x4 acc = (f32x4){0.f, 0.f, 0.f, 0.f};
#pragma unroll
              for (int kk = 0; kk < 64; kk += 32) acc = mfma16(ldsfrag(sQ, 72, tm * 16 + l15, kk + lq * 8), ldsfrag(sK, 72, tn * 16 + l15, kk + lq * 8), acc);
              const int s = tn * 16 + l15;
#pragma unroll
              for (int r = 0; r < 4; ++r) { const int t = tm * 16 + lq * 4 + r; const bool keep = dir ? (s >= t) : (s <= t); sAt[t * 72 + s] = f2bf1(keep ? acc[r] : 0.f); } } }
        __syncthreads();
#pragma unroll
        for (int tm = 0; tm < 4; ++tm) { f32x4 acc = (f32x4){0.f, 0.f, 0.f, 0.f};
#pragma unroll
            for (int kk = 0; kk < 64; kk += 32) acc = mfma16(ldsfrag(sAt, 72, tm * 16 + l15, kk + lq * 8), ldsfrag(sVt, 72, wid * 16 + l15, kk + lq * 8), acc);
#pragma unroll
            for (int kk = 0; kk < 64; kk += 32) acc = mfma16(ldsfrag(sQ, 72, tm * 16 + l15, kk + lq * 8), ldsfrag(sSt, 72, wid * 16 + l15, kk + lq * 8), acc);
#pragma unroll
            for (int r = 0; r < 4; ++r) { const int t = tm * 16 + lq * 4 + r; R1[(size_t)(row0 + t) * 1024 + dir * 512 + h * 128 + wid * 16 + l15] = f2bf1(acc[r]); } }
#pragma unroll
        for (int kb = 0; kb < 4; ++kb) {
#pragma unroll
            for (int r = 0; r < 4; ++r) S[kb][r] *= sDec[kb * 16 + lq * 4 + r];
#pragma unroll
            for (int kk = 0; kk < 64; kk += 32) S[kb] = mfma16(ldsfrag(sKe, 72, kb * 16 + l15, kk + lq * 8), ldsfrag(sVt, 72, wid * 16 + l15, kk + lq * 8), S[kb]);
            *(uint2*)(sSt + (wid * 16 + l15) * 72 + kb * 16 + lq * 4) = pack4(S[kb]); }
        if (step + 1 < 36) { const int idx = tid * 2, t = idx >> 4, r = idx & 15; sR[t * 16 + r] = rr.x; sR[t * 16 + r + 1] = rr.y; }
        __syncthreads();
    }
}

DEVI void phase_ml_conv(const Params& p, unsigned char* shm) {
    f32x4* sCwAll = (f32x4*)shm;
    const int tid = tid_l();
    const bf16_t* RAW = (const bf16_t*)(WSP() + OFF_R2);
    bf16_t* P = (bf16_t*)(WSP() + OFF_P);
    { const float* cw = INP(17); const float* cb = INP(18);
      for (int i = tid; i < 1024; i += 512) sCwAll[i] = (f32x4){cw[i], cw[1024 + i], cw[2048 + i], cb[i]}; }
    __syncthreads();
    const int ntask = (MTOT / 2) * 128;
    for (int i = bid_l() * 512 + tid; i < ntask; i += gridDim.x * 512) {
        const int v = i & 127, pr = i >> 7, r0 = pr * 2;
        int pos, seqlen;
        if (r0 < MLAT) { pos = r0 & (TL - 1); seqlen = TL; } else { pos = (r0 - MLAT) & (TC - 1); seqlen = TC; }
        const bool v0 = pos >= 1, v3 = pos + 2 < seqlen;
        const bf16_t* base = RAW + (size_t)r0 * 1024 + v * 8;
        const long om = v0 ? -1024l : 0l, o3 = v3 ? 2048l : 1024l;
        const bf16x8 a0 = *(const bf16x8*)(base + om), a1 = *(const bf16x8*)(base), a2 = *(const bf16x8*)(base + 1024), a3 = *(const bf16x8*)(base + o3);
        bf16x8 oa, ob; conv2x8(a0, a1, a2, a3, v0, v3, sCwAll + v * 8, oa, ob);
        if (v >= 64) { float x[8], y[8]; unpack8(oa, x); unpack8(ob, y);
#pragma unroll
            for (int e = 0; e < 8; ++e) { x[e] *= 0.08838834764831845f; y[e] *= 0.08838834764831845f; }
            oa = packf8(x); ob = packf8(y); }
        *(bf16x8*)(P + (size_t)r0 * PLD + 1536 + v * 8) = oa; *(bf16x8*)(P + (size_t)(r0 + 1) * PLD + 1536 + v * 8) = ob;
    }
}

DEVI void mlstm_chain(const Params& p, int b, int h, int dir, unsigned char* shm) {
    bf16_t* sQ = (bf16_t*)shm;
    bf16_t* sK = sQ + 64 * 136;
    bf16_t* sV = sK + 64 * 136;
    bf16_t* sH = sV + 64 * 136;
    bf16_t* sSc = sH + 64 * 136;
    bf16_t* sCt = sSc + 64 * 72;
    float* sRow = (float*)(sCt + 144 * 136);
    float* sU = sRow + 64;
    float* sAw = sU + 64;
    float* sWs = sAw + 64;
    float* sEmt = sWs + 64;
    float* sDen = sEmt + 64;
    float* sScal = sDen + 64;
    f32x4* sCw = (f32x4*)(sScal + 4);
    const int tid = tid_l(), wid = tid >> 6, lane = tid & 63, l15 = lane & 15, lq = lane >> 4;
    const bf16_t* P = (const bf16_t*)(WSP() + OFF_P);
    const float* F = (const float*)(WSP() + OFF_F32);
    bf16_t* R2 = (bf16_t*)(WSP() + OFF_R2);
    const int vc = tid & 15, tp = tid >> 4;
    const float gb_i = INP(19)[(dir * 2) * 4 + h], gb_f = INP(19)[(dir * 2 + 1) * 4 + h];
    f32x4 C[8], Cn;
#pragma unroll
    for (int i = 0; i < 8; ++i) C[i] = (f32x4){0.f, 0.f, 0.f, 0.f};
    Cn = (f32x4){0.f, 0.f, 0.f, 0.f};
    float mcar = 0.f;
    __syncthreads();
    for (int i = tid; i < 144 * 136 / 2; i += 512) ((unsigned*)sCt)[i] = 0u;
    __syncthreads();
    bf16x8 Rq[2], Rk[2], Rv[2]; float gli = 0.f, glf = 0.f;
    auto issue = [&](int step) {
        int row0, pos0, seqlen; bool ic; chain_chunk(b, dir, step, row0, pos0, seqlen, ic);
        const int t0 = tp * 2;
        const bf16_t* base = P + (size_t)(row0 + t0) * PLD + h * 128 + vc * 8;
        Rq[0] = *(const bf16x8*)(base + 1536); Rq[1] = *(const bf16x8*)(base + 1536 + PLD);
        Rk[0] = *(const bf16x8*)(base + 2048); Rk[1] = *(const bf16x8*)(base + 2048 + PLD);
        Rv[0] = *(const bf16x8*)(base + 2560); Rv[1] = *(const bf16x8*)(base + 2560 + PLD);
        if (wid == 0) { const int t = dir ? 63 - lane : lane; gli = F[(size_t)(row0 + t) * FLD + (dir * 2) * 4 + h]; glf = F[(size_t)(row0 + t) * FLD + (dir * 2 + 1) * 4 + h]; } };
    issue(0);
    for (int step = 0; step < 36; ++step) {
        int row0, pos0, seqlen; bool is_ctx; chain_chunk(b, dir, step, row0, pos0, seqlen, is_ctx);
        if (wid == 0) {
            const int j = lane, t = dir ? 63 - j : j;
            const float li = gli + gb_i;
            const float lf = logsig_f(glf + gb_f);
            float bsum = lf;
#pragma unroll
            for (int o = 1; o < 64; o <<= 1) { const float n = __shfl_up(bsum, o); if (j >= o) bsum += n; }
            const float u = li - bsum;
            float pmx = u;
#pragma unroll
            for (int o = 1; o < 64; o <<= 1) { const float n = __shfl_up(pmx, o); if (j >= o) pmx = fmaxf(pmx, n); }
            const float pm63 = __shfl(pmx, 63), bend = __shfl(bsum, 63);
            const float Mx = fmaxf(mcar, pm63);
            const float mt = fmaxf(mcar, pmx);
            sRow[t] = -mt; sU[t] = u; sAw[t] = __expf(mcar - mt); sWs[t] = __expf(u - Mx); sEmt[t] = __expf(-(bsum + mt));
            if (j == 0) sScal[0] = __expf(mcar - Mx);
            mcar = bend + Mx;
        }
        {
            const int t0 = tp * 2;
            *(bf16x8*)(sQ + t0 * 136 + vc * 8) = Rq[0]; *(bf16x8*)(sQ + (t0 + 1) * 136 + vc * 8) = Rq[1];
            *(bf16x8*)(sK + t0 * 136 + vc * 8) = Rk[0]; *(bf16x8*)(sK + (t0 + 1) * 136 + vc * 8) = Rk[1];
            *(bf16x8*)(sV + t0 * 136 + vc * 8) = Rv[0]; *(bf16x8*)(sV + (t0 + 1) * 136 + vc * 8) = Rv[1];
            if (step + 1 < 36) issue(step + 1);
        }
        __syncthreads();
        { const int tm = wid >> 1;
#pragma unroll
          for (int q = 0; q < 2; ++q) { const int tn = (wid & 1) * 2 + q; f32x4 acc = (f32x4){0.f, 0.f, 0.f, 0.f};
#pragma unroll
              for (int kk = 0; kk < 128; kk += 32) acc = mfma16(ldsfrag(sQ, 136, tm * 16 + l15, kk + lq * 8), ldsfrag(sK, 136, tn * 16 + l15, kk + lq * 8), acc);
              const int s_ = tn * 16 + l15; const float us = sU[s_];
#pragma unroll
              for (int r = 0; r < 4; ++r) { const int t = tm * 16 + lq * 4 + r; const bool keep = dir ? (s_ >= t) : (s_ <= t);
                  sSc[t * 72 + s_] = f2bf1(keep ? acc[r] * __expf(sRow[t] + us) : 0.f); } } }
        __syncthreads();
        f32x4 num[4];
        { const bf16x8 bv0 = tr_frag<136>(sV, 0, wid * 16, l15, lq), bv1 = tr_frag<136>(sV, 32, wid * 16, l15, lq);
#pragma unroll
          for (int tm = 0; tm < 4; ++tm) { f32x4 acc = (f32x4){0.f, 0.f, 0.f, 0.f};
#pragma unroll
              for (int kk = 0; kk < 128; kk += 32) acc = mfma16(ldsfrag(sQ, 136, tm * 16 + l15, kk + lq * 8), ldsfrag(sCt, 136, wid * 16 + l15, kk + lq * 8), acc);
#pragma unroll
              for (int r = 0; r < 4; ++r) acc[r] *= sAw[tm * 16 + lq * 4 + r];
              acc = mfma16(ldsfrag(sSc, 72, tm * 16 + l15, lq * 8), bv0, acc);
              acc = mfma16(ldsfrag(sSc, 72, tm * 16 + l15, 32 + lq * 8), bv1, acc);
              num[tm] = acc; } }
        if (wid < 4) { const int tm = wid; f32x4 acc = (f32x4){0.f, 0.f, 0.f, 0.f};
            const short one = (l15 == 0) ? (short)0x3F80 : (short)0; const bf16x8 ones = {one, one, one, one, one, one, one, one};
#pragma unroll
            for (int kk = 0; kk < 128; kk += 32) acc = mfma16(ldsfrag(sQ, 136, tm * 16 + l15, kk + lq * 8), ldsfrag(sCt, 136, 128 + l15, kk + lq * 8), acc);
#pragma unroll
            for (int r = 0; r < 4; ++r) acc[r] *= sAw[tm * 16 + lq * 4 + r];
#pragma unroll
            for (int kk = 0; kk < 64; kk += 32) acc = mfma16(ldsfrag(sSc, 72, tm * 16 + l15, kk + lq * 8), ones, acc);
            if (l15 == 0) {
#pragma unroll
                for (int r = 0; r < 4; ++r) sDen[tm * 16 + lq * 4 + r] = acc[r]; } }
        __syncthreads();
#pragma unroll
        for (int tm = 0; tm < 4; ++tm) {
#pragma unroll
            for (int r = 0; r < 4; ++r) { const int t = tm * 16 + lq * 4 + r; const float dn = fmaxf(fabsf(sDen[t]), sEmt[t]);
                sH[t * 136 + wid * 16 + l15] = f2bf1(num[tm][r] * __builtin_amdgcn_rcpf(dn)); } }
        { const float decay = sScal[0];
          bf16x8 bw[2], bn[2];
#pragma unroll
          for (int q = 0; q < 2; ++q) { float xv[8], wv[8]; unpack8(tr_frag<136>(sV, 32 * q, wid * 16, l15, lq), xv);
#pragma unroll
              for (int e = 0; e < 8; ++e) { const float w_ = sWs[32 * q + lq * 8 + e]; xv[e] *= w_; wv[e] = (l15 == 0) ? w_ : 0.f; }
              bw[q] = packf8(xv); bn[q] = packf8(wv); }
#pragma unroll
          for (int kb = 0; kb < 8; ++kb) { C[kb] *= decay;
#pragma unroll
              for (int q = 0; q < 2; ++q) C[kb] = mfma16(tr_frag<136>(sK, 32 * q, kb * 16, l15, lq), bw[q], C[kb]);
              *(uint2*)(sCt + (wid * 16 + l15) * 136 + kb * 16 + lq * 4) = pack4(C[kb]); }
          Cn *= decay;
#pragma unroll
          for (int q = 0; q < 2; ++q) Cn = mfma16(tr_frag<136>(sK, 32 * q, wid * 16, l15, lq), bn[q], Cn);
          *(uint2*)(sCt + (128 + l15) * 136 + wid * 16 + lq * 4) = pack4(Cn); }
        __syncthreads();
#pragma unroll
        for (int i = 0; i < 2; ++i) { const int v = tid + 512 * i, row = v >> 4, cv = v & 15;
            *(bf16x8*)(R2 + (size_t)(row0 + row) * 1024 + dir * 512 + h * 128 + cv * 8) = *(const bf16x8*)(sH + row * 136 + cv * 8); }
    }
}

DEVI void phase_ssd_conv(const Params& p, unsigned char* shm) {
    f32x4* sCwAll = (f32x4*)shm;
    const int tid = tid_l();
    const bf16_t* XBC = (const bf16_t*)(WSP() + OFF_XBC);
    bf16_t* XC = (bf16_t*)(WSP() + OFF_XBCC);
    { const float* cw = INP(24); const float* cb = INP(25);
      for (int i = tid; i < 3072; i += 512) sCwAll[i] = (f32x4){cw[i], cw[3072 + i], cw[6144 + i], cb[i]}; }
    __syncthreads();
    const int ntask = (SLABM / 2) * 384;
    for (int i = bid_l() * 512 + tid; i < ntask; i += gridDim.x * 512) {
        const int v = i % 384, pr = i / 384, r0 = pr * 2;
        int pos, seqlen;
        if (r0 < SLABL) { pos = r0 & (TL - 1); seqlen = TL; } else { pos = (r0 - SLABL) & (TC - 1); seqlen = TC; }
        const bool v0 = pos >= 1, v3 = pos + 2 < seqlen;
        const bf16_t* base = XBC + (size_t)r0 * 3072 + v * 8;
        const long om = v0 ? -3072l : 0l, o3 = v3 ? 6144l : 3072l;
        const bf16x8 a0 = *(const bf16x8*)(base + om), a1 = *(const bf16x8*)(base), a2 = *(const bf16x8*)(base + 3072), a3 = *(const bf16x8*)(base + o3);
        bf16x8 oa, ob; conv2x8(a0, a1, a2, a3, v0, v3, sCwAll + v * 8, oa, ob);
        *(bf16x8*)(XC + (size_t)r0 * 3072 + v * 8) = oa; *(bf16x8*)(XC + (size_t)(r0 + 1) * 3072 + v * 8) = ob;
    }
}

DEVI void ssd_chain(const Params& p, int slab, int lb, int g, int hp, int dir, unsigned char* shm) {
    bf16_t* sC = (bf16_t*)shm;
    bf16_t* sB = sC + 64 * 136;
    bf16_t* sX = sB + 64 * 136;
    bf16_t* sW = sX + 64 * 136;
    bf16_t* sS = sW + 2 * 64 * 72;
    float* sCum = (float*)(sS + 2 * 64 * 136);
    float* sDt = sCum + 128;
    float* sWend = sDt + 128;
    float* sEcum = sWend + 128;
    float* sDec = sEcum + 128;
    f32x4* sCw = (f32x4*)(sDec + 4);
    const int tid = tid_l(), wid = tid >> 6, lane = tid & 63, l15 = lane & 15, lq = lane >> 4;
    const bf16_t* XBC = (const bf16_t*)(WSP() + OFF_XBCC);
    const float* DT = (const float*)(WSP() + OFF_DT);
    bf16_t* Y = (bf16_t*)(WSP() + (dir ? OFF_YB : OFF_YF));
    const int h0 = g * 8 + hp * 2;
    const int vc = tid & 15, tp = tid >> 4;
    const int hh = wid >> 2, pq = wid & 3;
    const int hmine = h0 + hh;
    const float Dh = INP(28)[hmine];
    const int hdt = h0 + (wid & 1);
    const float dtb = INP(26)[dir * 32 + hdt], Ah = -__expf(INP(27)[dir * 32 + hdt]);
    f32x4 St[8];
#pragma unroll
    for (int i = 0; i < 8; ++i) St[i] = (f32x4){0.f, 0.f, 0.f, 0.f};
    __syncthreads();
    for (int i = tid; i < 2 * 64 * 136 / 2; i += 512) ((unsigned*)sS)[i] = 0u;
    __syncthreads();
    bf16x8 R[3][2]; float dtr = 0.f;
    auto chunk_of = [&](int step, int& pos0, int& seqlen, int& lrow0, bool& is_ctx) {
        if (step < 4) { const int cc = dir ? 3 - step : step; is_ctx = true; pos0 = cc * 64; seqlen = TC; lrow0 = SLABL + lb * TC + pos0; }
        else { const int cc = dir ? 31 - (step - 4) : (step - 4); is_ctx = false; pos0 = cc * 64; seqlen = TL; lrow0 = lb * TL + pos0; } };
    auto issue = [&](int step) {
        int pos0, seqlen, lrow0; bool ic; chunk_of(step, pos0, seqlen, lrow0, ic);
        const int t0 = tp * 2;
        const bf16_t* base = XBC + (size_t)(lrow0 + t0) * 3072 + vc * 8;
#pragma unroll
        for (int m = 0; m < 3; ++m) { const int cb = (m == 0 ? 2048 + g * 128 : (m == 1 ? 2560 + g * 128 : h0 * 64));
            R[m][0] = *(const bf16x8*)(base + cb); R[m][1] = *(const bf16x8*)(base + cb + 3072); }
        if (wid < 2) { const int t = dir ? 63 - lane : lane; dtr = DT[(size_t)(lrow0 + t) * 64 + dir * 32 + hdt]; } };
    issue(0);
    for (int step = 0; step < 36; ++step) {
        int pos0, seqlen, lrow0; bool is_ctx; chunk_of(step, pos0, seqlen, lrow0, is_ctx);
        if (wid < 2) {
            const int j = lane, t = dir ? 63 - j : j;
            const float dt = softplus_f(dtr + dtb);
            float cum = dt * Ah;
#pragma unroll
            for (int o = 1; o < 64; o <<= 1) { const float n = __shfl_up(cum, o); if (j >= o) cum += n; }
            const float cend = __shfl(cum, 63);
            sCum[wid * 64 + t] = cum; sDt[wid * 64 + t] = dt; sWend[wid * 64 + t] = __expf(cend - cum) * dt; sEcum[wid * 64 + t] = __expf(cum);
            if (j == 0) sDec[wid] = __expf(cend);
        }
        {
            const int t0 = tp * 2;
#pragma unroll
            for (int m = 0; m < 3; ++m) {
                if (m == 1 && is_ctx) continue;
                bf16_t* dst = (m == 0 ? sB : (m == 1 ? sC : sX));
                *(bf16x8*)(dst + t0 * 136 + vc * 8) = R[m][0]; *(bf16x8*)(dst + (t0 + 1) * 136 + vc * 8) = R[m][1]; }
            if (step + 1 < 36) issue(step + 1);
        }
        __syncthreads();
        if (!is_ctx) { const int tm = wid >> 1;
#pragma unroll
          for (int q = 0; q < 2; ++q) { const int tn = (wid & 1) * 2 + q; f32x4 acc = (f32x4){0.f, 0.f, 0.f, 0.f};
#pragma unroll
              for (int kk = 0; kk < 128; kk += 32) acc = mfma16(ldsfrag(sC, 136, tm * 16 + l15, kk + lq * 8), ldsfrag(sB, 136, tn * 16 + l15, kk + lq * 8), acc);
              const int s_ = tn * 16 + l15;
#pragma unroll
              for (int h2 = 0; h2 < 2; ++h2) { const float cs = sCum[h2 * 64 + s_], ds = sDt[h2 * 64 + s_]; const f32x4 ct = *(const f32x4*)(sCum + h2 * 64 + tm * 16 + lq * 4);
#pragma unroll
                  for (int r = 0; r < 4; ++r) { const int t = tm * 16 + lq * 4 + r; const bool keep = dir ? (s_ >= t) : (s_ <= t);
                      sW[(h2 * 64 + t) * 72 + s_] = f2bf1(keep ? acc[r] * __expf(ct[r] - cs) * ds : 0.f); } } } }
        __syncthreads();
        const bf16_t* sSh = sS + hh * 64 * 136;
        const bf16x8 bx0 = tr_frag<136>(sX, 0, hh * 64 + pq * 16, l15, lq), bx1 = tr_frag<136>(sX, 32, hh * 64 + pq * 16, l15, lq);
        if (!is_ctx) {
#pragma unroll
            for (int tm = 0; tm < 4; ++tm) { f32x4 acc = (f32x4){0.f, 0.f, 0.f, 0.f};
#pragma unroll
                for (int kk = 0; kk < 128; kk += 32) acc = mfma16(ldsfrag(sC, 136, tm * 16 + l15, kk + lq * 8), ldsfrag(sSh, 136, pq * 16 + l15, kk + lq * 8), acc);
                { const f32x4 ec = *(const f32x4*)(sEcum + hh * 64 + tm * 16 + lq * 4);
#pragma unroll
                  for (int r = 0; r < 4; ++r) acc[r] *= ec[r]; }
                acc = mfma16(ldsfrag(sW, 72, hh * 64 + tm * 16 + l15, lq * 8), bx0, acc);
                acc = mfma16(ldsfrag(sW, 72, hh * 64 + tm * 16 + l15, 32 + lq * 8), bx1, acc);
                if (!dir) {
#pragma unroll
                    for (int r = 0; r < 4; ++r) acc[r] += Dh * bf2f(sX[(tm * 16 + lq * 4 + r) * 136 + hh * 64 + pq * 16 + l15]); }
#pragma unroll
                for (int r = 0; r < 4; ++r) Y[(size_t)(lrow0 + tm * 16 + lq * 4 + r) * 2048 + hmine * 64 + pq * 16 + l15] = f2bf1(acc[r]); }
        }
        { bf16x8 bx[2];
#pragma unroll
          for (int q = 0; q < 2; ++q) { float xv[8]; unpack8(q ? bx1 : bx0, xv);
#pragma unroll
              for (int e = 0; e < 8; ++e) xv[e] *= sWend[hh * 64 + q * 32 + lq * 8 + e];
              bx[q] = packf8(xv); }
          const float dec = sDec[hh];
#pragma unroll
          for (int nb = 0; nb < 8; ++nb) { St[nb] *= dec;
#pragma unroll
              for (int q = 0; q < 2; ++q) St[nb] = mfma16(tr_frag<136>(sB, q * 32, nb * 16, l15, lq), bx[q], St[nb]);
              *(uint2*)(sS + hh * 64 * 136 + (pq * 16 + l15) * 136 + nb * 16 + lq * 4) = pack4(St[nb]); } }
        __syncthreads();
    }
}

DEVI float sum16(float v) { v += __shfl_xor(v, 1); v += __shfl_xor(v, 2); v += __shfl_xor(v, 4); v += __shfl_xor(v, 8); return v; }
DEVI void phase_even_combine(const Params& p) {
    const int tid_ = tid_l(); const int wid = tid_ >> 6, lane = tid_ & 63;
    const bf16_t* P = (const bf16_t*)(WSP() + OFF_P);
    bf16_t* R1 = (bf16_t*)(WSP() + OFF_H);
    const bf16_t* R2 = (const bf16_t*)(WSP() + OFF_R2);
    float gn[8], mn[8];
#pragma unroll
    for (int e = 0; e < 8; ++e) { gn[e] = INP(20)[lane * 8 + e]; mn[e] = INP(21)[lane * 8 + e]; }
    const int stride = gridDim.x * 8;
    int row = bid_l() * 8 + wid;
    bf16x8 c[6], n[6];
    auto ldrow = [&](int r, bf16x8 (&d)[6]) {
        d[0] = *(const bf16x8*)(R1 + (size_t)r * 1024 + lane * 8); d[1] = *(const bf16x8*)(R1 + (size_t)r * 1024 + 512 + lane * 8);
        d[2] = *(const bf16x8*)(P + (size_t)r * PLD + 1024 + lane * 8); d[3] = *(const bf16x8*)(R2 + (size_t)r * 1024 + lane * 8);
        d[4] = *(const bf16x8*)(R2 + (size_t)r * 1024 + 512 + lane * 8); d[5] = *(const bf16x8*)(P + (size_t)r * PLD + 3072 + lane * 8); };
    if (row < MTOT) ldrow(row, c);
    for (; row < MTOT; row += stride) {
        if (row + stride < MTOT) ldrow(row + stride, n);
        float of[8], ob[8], gg[8], hf[8], hb[8], mo[8];
        unpack8(c[0], of); unpack8(c[1], ob); unpack8(c[2], gg); unpack8(c[3], hf); unpack8(c[4], hb); unpack8(c[5], mo);
        float s1 = 0.f, s2 = 0.f;
#pragma unroll
        for (int e = 0; e < 8; ++e) { of[e] += ob[e]; s1 += of[e] * of[e]; hf[e] = sigmoid_f(mo[e]) * (hf[e] + hb[e]); s2 += hf[e] * hf[e]; }
        s1 = sum16(s1); s2 = sum16(s2);
        const float r1 = rsqrtf(s1 * (1.f / 128.f) + 1e-6f), r2 = rsqrtf(s2 * (1.f / 128.f) + 1e-6f);
#pragma unroll
        for (int e = 0; e < 8; ++e) { of[e] = of[e] * r1 * gn[e] * silu_f(gg[e]); hf[e] = hf[e] * r2 * mn[e]; }
        *(bf16x8*)(R1 + (size_t)row * 1024 + lane * 8) = packf8(of);
        *(bf16x8*)(R1 + (size_t)row * 1024 + 512 + lane * 8) = packf8(hf);
#pragma unroll
        for (int i = 0; i < 6; ++i) c[i] = n[i];
    }
}
DEVI void phase_odd_combine(const Params& p) {
    const int tid_ = tid_l(); const int wid = tid_ >> 6, lane = tid_ & 63;
    bf16_t* Z = (bf16_t*)(WSP() + OFF_Z);
    const bf16_t* YF = (const bf16_t*)(WSP() + OFF_YF);
    const bf16_t* YB = (const bf16_t*)(WSP() + OFF_YB);
    const float* ng = INP(29);
    f32x4 ngv[4][2];
#pragma unroll
    for (int gi = 0; gi < 4; ++gi) { ngv[gi][0] = *(const f32x4*)(ng + gi * 512 + lane * 8); ngv[gi][1] = *(const f32x4*)(ng + gi * 512 + lane * 8 + 4); }
    const int stride = gridDim.x * 8;
    int row = bid_l() * 8 + wid;
    bf16x8 c[12], n[12];
    auto ldrow = [&](int r, bf16x8 (&d)[12]) {
#pragma unroll
        for (int gi = 0; gi < 4; ++gi) { const int ch = gi * 512 + lane * 8;
            d[gi * 3] = *(const bf16x8*)(YF + (size_t)r * 2048 + ch); d[gi * 3 + 1] = *(const bf16x8*)(YB + (size_t)r * 2048 + ch); d[gi * 3 + 2] = *(const bf16x8*)(Z + (size_t)r * 2048 + ch); } };
    if (row < SLABL) ldrow(row, c);
    for (; row < SLABL; row += stride) {
        if (row + stride < SLABL) ldrow(row + stride, n);
#pragma unroll
        for (int gi = 0; gi < 4; ++gi) { const int ch = gi * 512 + lane * 8; float yf[8], yb[8], z[8];
            unpack8(c[gi * 3], yf); unpack8(c[gi * 3 + 1], yb); unpack8(c[gi * 3 + 2], z);
            float ss = 0.f;
#pragma unroll
            for (int e = 0; e < 8; ++e) { yf[e] = (yf[e] + yb[e]) * silu_f(z[e]); ss += yf[e] * yf[e]; }
            ss = wave_sum(ss);
            const float rs = rsqrtf(ss * (1.f / 512.f) + 1e-6f);
#pragma unroll
            for (int e = 0; e < 8; ++e) yf[e] = yf[e] * rs * ngv[gi][e >> 2][e & 3];
            *(bf16x8*)(Z + (size_t)row * 2048 + ch) = packf8(yf); }
#pragma unroll
        for (int i = 0; i < 12; ++i) c[i] = n[i];
    }
}

DEVI void phase_convact(const Params& p, int layer, int grp, bool with_ctx) {
    const int tid = tid_l(), wid = tid >> 6, lane = tid & 63;
    const int w = grp == 2 ? 768 : 1024, j0 = grp * 1024, ldu = 2 * w, nvb = w / 256;
    const int segw = grp == 2 ? 8 : 32, nseg = 64 / segw;
    const bf16_t* U = (const bf16_t*)(WSP() + OFF_U);
    bf16_t* ACT = (bf16_t*)(WSP() + OFF_ACT);
    const float* cw = INP(10) + (size_t)layer * 9 * NUP;
    const float* cbias = INP(11) + (size_t)layer * NUP;
    const int nlat = 16 * 2 * nvb * nseg, nctx = with_ctx ? 16 * nvb * 4 : 0;
    for (int u = bid_l(); u < nlat + nctx; u += gridDim.x) {
        int img_row0, H, Wd, r0, c0, nc, vb;
        if (u < nlat) { int q = u; const int seg = q % nseg; q /= nseg; vb = q % nvb; q /= nvb; const int band = q & 1; const int img = q >> 1;
            img_row0 = img * TL; H = 32; Wd = 64; r0 = band * 16 + wid * 2; c0 = seg * segw; nc = segw; }
        else { int q = u - nlat; const int quarter = q & 3; q >>= 2; vb = q % nvb; const int img = q / nvb; img_row0 = MLAT + img * TC; H = 1; Wd = 256; r0 = 0; c0 = quarter * 64 + wid * 8; nc = 8; }
        const bool two = (r0 + 1 < H);
        const int j = vb * 256 + lane * 4;
        const int cha = j0 + j, chg = 2816 + j0 + j;
        float wa[9][4], wg[9][4], ba[4], bg[4];
#pragma unroll
        for (int q = 0; q < 9; ++q) { const f32x4 a = *(const f32x4*)(cw + q * NUP + cha), g = *(const f32x4*)(cw + q * NUP + chg);
#pragma unroll
            for (int e = 0; e < 4; ++e) { wa[q][e] = a[e]; wg[q][e] = g[e]; } }
        { const f32x4 a = *(const f32x4*)(cbias + cha), g = *(const f32x4*)(cbias + chg);
#pragma unroll
          for (int e = 0; e < 4; ++e) { ba[e] = a[e]; bg[e] = g[e]; } }
        f32x4 Wa[4][3], Wg[4][3]; uint2 Na[4], Ng[4];
        auto ld = [&](int rr, int cc, uint2& va, uint2& vg) {
            const bool ok = rr >= 0 && rr < H && cc >= 0 && cc < Wd;
            const int rc = min(max(rr, 0), H - 1), ccl = min(max(cc, 0), Wd - 1);
            const bf16_t* q = U + (size_t)(img_row0 + rc * Wd + ccl) * ldu + j; va = *(const uint2*)q; vg = *(const uint2*)(q + w);
            if (!ok) { va = make_uint2(0u, 0u); vg = make_uint2(0u, 0u); } };
        auto up = [&](uint2 a) { f32x4 r; r[0] = __uint_as_float(a.x << 16); r[1] = __uint_as_float(a.x & 0xFFFF0000u); r[2] = __uint_as_float(a.y << 16); r[3] = __uint_as_float(a.y & 0xFFFF0000u); return r; };
#pragma unroll
        for (int dy = 0; dy < 4; ++dy) { uint2 a, g; ld(r0 + dy - 1, c0 - 1, a, g); Wa[dy][1] = up(a); Wg[dy][1] = up(g); ld(r0 + dy - 1, c0, a, g); Wa[dy][2] = up(a); Wg[dy][2] = up(g); ld(r0 + dy - 1, c0 + 1, Na[dy], Ng[dy]); }
#pragma unroll 3
        for (int cc = c0; cc < c0 + nc; ++cc) {
#pragma unroll
            for (int dy = 0; dy < 4; ++dy) { Wa[dy][0] = Wa[dy][1]; Wa[dy][1] = Wa[dy][2]; Wa[dy][2] = up(Na[dy]); Wg[dy][0] = Wg[dy][1]; Wg[dy][1] = Wg[dy][2]; Wg[dy][2] = up(Ng[dy]); }
#pragma unroll
            for (int dy = 0; dy < 4; ++dy) ld(r0 + dy - 1, cc + 2, Na[dy], Ng[dy]);
            float sa[2][4], sg[2][4];
#pragma unroll
            for (int o = 0; o < 2; ++o)
#pragma unroll
                for (int e = 0; e < 4; ++e) { sa[o][e] = ba[e]; sg[o][e] = bg[e]; }
#pragma unroll
            for (int dy = 0; dy < 4; ++dy)
#pragma unroll
                for (int dx = 0; dx < 3; ++dx) { const f32x4 a = Wa[dy][dx], g = Wg[dy][dx];
                    if (dy < 3) { const int q = dy * 3 + dx;
#pragma unroll
                        for (int e = 0; e < 4; ++e) { sa[0][e] += wa[q][e] * a[e]; sg[0][e] += wg[q][e] * g[e]; } }
                    if (dy >= 1) { const int q = (dy - 1) * 3 + dx;
#pragma unroll
                        for (int e = 0; e < 4; ++e) { sa[1][e] += wa[q][e] * a[e]; sg[1][e] += wg[q][e] * g[e]; } } }
            { uint2 o; o.x = pack2(silu_f(sg[0][0]) * sa[0][0], silu_f(sg[0][1]) * sa[0][1]); o.y = pack2(silu_f(sg[0][2]) * sa[0][2], silu_f(sg[0][3]) * sa[0][3]);
              *(uint2*)(ACT + (size_t)(img_row0 + r0 * Wd + cc) * DFF + j0 + j) = o; }
            if (two) { uint2 o; o.x = pack2(silu_f(sg[1][0]) * sa[1][0], silu_f(sg[1][1]) * sa[1][1]); o.y = pack2(silu_f(sg[1][2]) * sa[1][2], silu_f(sg[1][3]) * sa[1][3]);
              *(uint2*)(ACT + (size_t)(img_row0 + (r0 + 1) * Wd + cc) * DFF + j0 + j) = o; }
        }
    }
}

#define XB_TMO      128
#define XB_XCNT(j)  (256  + 64 * (j))
#define XB_XSUB(j)  (1280 + 64 * (j))
#define XB_XGEN(j)  (2304 + 64 * (j))
#define XB_TOP      3328
#define XB_TOPGEN   3392
#define XCD_BAR_WORDS 3456
#define XB_SPIN_CAP (1u << 22)
DEVI unsigned xb_ld(unsigned* p)              { return __hip_atomic_load(p, __ATOMIC_RELAXED, __HIP_MEMORY_SCOPE_AGENT); }
DEVI unsigned xb_add(unsigned* p, unsigned v) { return __hip_atomic_fetch_add(p, v, __ATOMIC_RELAXED, __HIP_MEMORY_SCOPE_AGENT); }
DEVI unsigned xb_xcc_id() { return (unsigned)__builtin_amdgcn_s_getreg((3 << 11) | 20) & 0xFu; }
#define XB_SPIN(cond, bar) do { unsigned _sp = 0; while (cond) { __builtin_amdgcn_s_sleep(1); \
    if ((++_sp & 255u) == 0u) { if (xb_ld(&(bar)[XB_TMO])) break; if (_sp > XB_SPIN_CAP) { atomicAdd(&(bar)[XB_TMO], 1u); break; } } } } while (0)
struct XcdBarrier { unsigned* bar; unsigned x; volatile LAS unsigned* st; };
DEVI XcdBarrier xcd_barrier_post(unsigned* bar, volatile LAS unsigned* st) {
    XcdBarrier b; b.bar = bar; b.x = xb_xcc_id(); b.st = st;
    if (threadIdx.x == 0) (void)xb_add(&bar[XB_XCNT(b.x)], 1u);
    return b;
}
DEVI void xcd_barrier_complete(unsigned* bar, unsigned x, unsigned& nloc, unsigned& nx) {
    const unsigned G = gridDim.x * gridDim.y * gridDim.z;
    unsigned sum, cnt, mine, sp = 0u;
    for (;;) {
        sum = 0u; cnt = 0u; mine = 0u;
#pragma unroll
        for (unsigned j = 0; j < 16; ++j) { const unsigned c = xb_ld(&bar[XB_XCNT(j)]); sum += c; cnt += (c > 0u) ? 1u : 0u; mine = (j == x) ? c : mine; }
        if (sum == G) break;
        __builtin_amdgcn_s_sleep(1);
        if ((++sp & 255u) == 0u) { if (xb_ld(&bar[XB_TMO])) break; if (sp > XB_SPIN_CAP) { atomicAdd(&bar[XB_TMO], 1u); break; } }
    }
    nloc = mine > 0u ? mine : 1u; nx = cnt > 0u ? cnt : 1u;
}
DEVI void xcd_barrier(const XcdBarrier& b) {
    asm volatile("s_waitcnt vmcnt(0)" ::: "memory");
    __syncthreads();
    if (threadIdx.x == 0) {
        unsigned* bar = b.bar;
        __builtin_amdgcn_s_waitcnt(0);
        unsigned nloc = b.st[0], nx = b.st[1];
        if (nloc == 0u) { xcd_barrier_complete(bar, b.x, nloc, nx); b.st[0] = nloc; b.st[1] = nx; }
        const unsigned old = xb_add(&bar[XB_XSUB(b.x)], 1u);
        const unsigned gen = old / nloc;
        if (old + 1u == (gen + 1u) * nloc) {
            __builtin_amdgcn_fence(__ATOMIC_RELEASE, "agent");
            asm volatile("s_waitcnt vmcnt(0)" ::: "memory");
            const unsigned og = xb_add(&bar[XB_TOP], 1u);
            const unsigned tg = og / nx;
            if (og + 1u == (tg + 1u) * nx) xb_add(&bar[XB_TOPGEN], 1u);
            else XB_SPIN(xb_ld(&bar[XB_TOPGEN]) == tg, bar);
            __builtin_amdgcn_fence(__ATOMIC_ACQUIRE, "agent");
            xb_add(&bar[XB_XGEN(b.x)], 1u);
            asm volatile("s_waitcnt vmcnt(0)" ::: "memory");
        } else {
            XB_SPIN(xb_ld(&bar[XB_XGEN(b.x)]) == gen, bar);
            __builtin_amdgcn_fence(__ATOMIC_ACQUIRE, "agent");
            asm volatile("s_waitcnt vmcnt(0)" ::: "memory");
        }
    }
    __syncthreads();
}
constexpr size_t OFF_BAR = OFF_MOD + 900 * 1024;
constexpr int LDS_CTL = 131072 + 64;

#ifndef ONLYG
#define ONLYG -1
#endif
#define GEN(x) (ONLYG < 0 || ONLYG == (x))
#ifndef REP
#define REP 0
#endif
#define REPEAT(bit, ...) do { __VA_ARGS__; if (REP & (bit)) { xcd_barrier(xbar); __VA_ARGS__; } } while (0)
__global__ void __launch_bounds__(512) mega(Params p) {
    extern __shared__ __attribute__((aligned(16))) unsigned char shm[];
    volatile LAS unsigned* xst = (volatile LAS unsigned*)((LAS unsigned char*)shm + LDS_CTL);
    if (threadIdx.x == 0) { xst[0] = 0u; xst[1] = 0u; }
    __syncthreads();
    XcdBarrier xbar = xcd_barrier_post((unsigned*)(WSP() + OFF_BAR), xst);
    int ph = 0;
#define PH_BEGIN if (ph >= PH_LO() && ph < PH_HI()) { unsigned char* ws = WSP(); bf16_t* Wb = (bf16_t*)(ws + OFF_W); bf16_t* Hb = (bf16_t*)(ws + OFF_H); float* Xc = (float*)(ws + OFF_XC); const float* MOD = (const float*)(ws + OFF_MOD); (void)Wb; (void)Hb; (void)Xc; (void)MOD;
#define PH_END if (ph + 1 < PH_HI()) { xcd_barrier(xbar); } } ++ph;
    PH_BEGIN if (GEN(0)) REPEAT(16, phase_prep(p, shm)); PH_END
    PH_BEGIN if (GEN(1)) REPEAT(64, phase_modulate(p, INP(0), INP(2), MTOT, INP(6), 0, 0, OUTP(), Xc)); PH_END
    PH_BEGIN if (GEN(2)) { EpiInL0 e{(bf16_t*)(ws + OFF_P), (float*)(ws + OFF_F32), (bf16_t*)(ws + OFF_R2)}; run_gemm(shm, Hb, Wb + W0IN, MTOT, N0IN, 1024, e); } PH_END
    PH_BEGIN if (GEN(3) || ONLYG == 33) phase_ml_conv(p, shm); PH_END
    PH_BEGIN
        REPEAT(1, for (int u = bid_l(); u < 256; u += gridDim.x) {
            const int s_ = (u & 7) + 8 * ((u >> 3) & 15), dir = u >> 7, kind = s_ & 1, h = (s_ >> 1) & 3, b = s_ >> 3;
            if (kind == 0) { if (GEN(3) || ONLYG == 33) mlstm_chain(p, b, h, dir, shm); } else { if (GEN(3) || ONLYG == 34) gla_chain(p, b, h, dir, shm); }
        });
    PH_END
    PH_BEGIN if (GEN(4)) phase_even_combine(p); PH_END
    PH_BEGIN if (GEN(5)) { EpiResid e{OUTP(), Xc, MOD, 2048, 0}; run_gemm(shm, Hb, Wb + W0OUT, MTOT, 1024, 1024, e); } PH_END
    PH_BEGIN if (GEN(1)) REPEAT(64, phase_modulate(p, OUTP(), Xc, MTOT, INP(7), 0, 3072)); PH_END
    for (int g = 0; g < 3; ++g) {
        PH_BEGIN if (GEN(7)) { EpiBf16 e{(bf16_t*)(ws + OFF_U), g == 2 ? 1536 : 2048}; REPEAT(8, run_gemm(shm, Hb, Wb + UP0 + (size_t)g * 2048 * 1024, MTOT, g == 2 ? 1536 : 2048, 1024, e)); } PH_END
        PH_BEGIN if (GEN(8)) REPEAT(4, phase_convact(p, 0, g, true)); PH_END
    }
    PH_BEGIN if (GEN(5)) { EpiResid e{OUTP(), Xc, MOD, 5120, 0}; run_gemm(shm, (const bf16_t*)(ws + OFF_ACT), Wb + DN0, MLAT, 1024, DFF, e); } PH_END
    PH_BEGIN
        if ((int)bid_l() < 64) { if (GEN(5)) { EpiResid e{OUTP(), Xc, MOD, 5120, MLAT}; run_gemm(shm, (const bf16_t*)(ws + OFF_ACT) + (size_t)MLAT * DFF, Wb + DN0, MCTX, 1024, DFF, e, 1 << 30, 0, 0, 64); } }
        else { if (GEN(1)) phase_modulate(p, OUTP(), Xc, MLAT, INP(6) + 1024, 1, 0, nullptr, nullptr, 0, 64); }
    PH_END
    PH_BEGIN if (GEN(1)) phase_modulate(p, OUTP(), Xc, MTOT, INP(6) + 1024, 1, 0, nullptr, nullptr, MLAT, 0); PH_END
    for (int slab = 0; slab < 2; ++slab) {
        PH_BEGIN if (GEN(15)) { EpiInL1 e{(bf16_t*)(ws + OFF_XBC), (bf16_t*)(ws + OFF_Z), (float*)(ws + OFF_DT)};
            run_gemm(shm, Hb, Wb + W1IN, SLABM, N1IN, 1024, e, 64, 64 * slab, 128 + 8 * slab); } PH_END
        PH_BEGIN if (GEN(16)) phase_ssd_conv(p, shm); PH_END
        PH_BEGIN if (GEN(16)) REPEAT(2, for (int u = bid_l(); u < 256; u += gridDim.x) { const int s_ = (u & 7) + 8 * ((u >> 3) & 3), j_ = u >> 5, dir = j_ & 1, hp = j_ >> 1, g = s_ & 3, lb = s_ >> 2; ssd_chain(p, slab, lb, g, hp, dir, shm); }); PH_END
        PH_BEGIN if (GEN(17)) phase_odd_combine(p); PH_END
        PH_BEGIN if (GEN(5)) { EpiResid e{OUTP(), Xc, MOD + 17 * 6144, 2048, SLABL * slab}; run_gemm(shm, (const bf16_t*)(ws + OFF_Z), Wb + W1OUT, SLABL, 1024, 2048, e); } PH_END
    }
    PH_BEGIN if (GEN(1)) REPEAT(64, phase_modulate(p, OUTP(), Xc, MLAT, INP(7) + 1024, 1, 3072)); PH_END
    for (int g = 0; g < 3; ++g) {
        PH_BEGIN if (GEN(7)) { EpiBf16 e{(bf16_t*)(ws + OFF_U), g == 2 ? 1536 : 2048}; REPEAT(8, run_gemm(shm, Hb, Wb + UP1 + (size_t)g * 2048 * 1024, MLAT, g == 2 ? 1536 : 2048, 1024, e)); } PH_END
        PH_BEGIN if (GEN(8)) REPEAT(4, phase_convact(p, 1, g, false)); PH_END
    }
    PH_BEGIN if (GEN(5)) { EpiResid e{OUTP(), Xc, MOD + 17 * 6144, 5120, 0}; run_gemm(shm, (const bf16_t*)(ws + OFF_ACT), Wb + DN1, MLAT, 1024, DFF, e); } PH_END
    PH_BEGIN if (REP & 32) { for (int i = 0; i < 20; ++i) cg::this_grid().sync(); } if (GEN(1)) phase_final_norm(p); PH_END
    if (PH_HI() > 4096) cg::this_grid().sync();
}

#ifndef N_LAUNCH_PER_PHASE
#define N_LAUNCH_PER_PHASE 0
#endif

extern "C" void kernel_launch(void* const* d_in, const int* in_sizes, int n_in, void* d_out, int out_size, void* d_ws, size_t ws_size, hipStream_t stream) {
    static int grid = 0;
    if (grid == 0) {
        if (n_in != 31 || ws_size < WS_NEED) { fprintf(stderr, "kernel_launch: unexpected n_in %d or ws_size %zu (< %zu)\n", n_in, ws_size, (size_t)WS_NEED); grid = -1; return; }
        int dev = 0, cus = 0, per_cu = 0;
        hipGetDevice(&dev);
        hipDeviceGetAttribute(&cus, hipDeviceAttributeMultiprocessorCount, dev);
        if (hipFuncSetAttribute((const void*)mega, hipFuncAttributeMaxDynamicSharedMemorySize, LDS_BYTES) != hipSuccess) { fprintf(stderr, "kernel_launch: hipFuncSetAttribute failed\n"); grid = -1; return; }
        hipOccupancyMaxActiveBlocksPerMultiprocessor(&per_cu, (const void*)mega, 512, LDS_BYTES);
        if (per_cu < 1) { fprintf(stderr, "kernel_launch: occupancy query says %d blocks per CU\n", per_cu); per_cu = 1; }
        (void)hipGetLastError();
        grid = cus * 1;
    }
    if (grid < 0) return;
    Params p{};
    for (int i = 0; i < 31; ++i) p.in[i] = (const float*)d_in[i];
    p.out = (float*)d_out; p.ws = (unsigned char*)d_ws;
#if N_LAUNCH_PER_PHASE
    for (int ph = 0; ph < NPHASE; ++ph) {
        p.ph_lo = ph; p.ph_hi = ph + 1;
        hipLaunchKernelGGL(mega, dim3(grid), dim3(512), LDS_BYTES, stream, p);
    }
#else
    p.ph_lo = 0; p.ph_hi = NPHASE;
    if (hipMemsetAsync((unsigned char*)d_ws + OFF_BAR, 0, XCD_BAR_WORDS * 4, stream) != hipSuccess) { fprintf(stderr, "kernel_launch: memset of barrier words failed\n"); return; }
    void* args[] = {&p};
    hipError_t e = hipLaunchCooperativeKernel((const void*)mega, dim3(grid), dim3(512), args, LDS_BYTES, stream);
    if (e != hipSuccess) fprintf(stderr, "cooperative launch failed: %s (grid %d)\n", hipGetErrorString(e), grid);
#endif
}
```

```cpp
#include <hip/hip_runtime.h>
#include <hip/hip_cooperative_groups.h>
#include <cstdio>
#include <cstdint>
namespace cg = cooperative_groups;

#define DEVI __device__ __forceinline__
#define LAS __attribute__((address_space(3)))
typedef unsigned short bf16_t;
typedef short bf16x8 __attribute__((ext_vector_type(8)));
typedef float f32x4 __attribute__((ext_vector_type(4)));

constexpr int NB = 16, TL = 2048, TC = 256, DM = 1024;
constexpr int MLAT = NB * TL;
constexpr int MCTX = NB * TC;
constexpr int MTOT = MLAT + MCTX;
constexpr int PLD = 3584;
constexpr int FLD = 48;
constexpr int N0IN = 3840, N1IN = 5376, DFF = 2816, NUP = 5632;
constexpr int SLABM = 18432, SLABL = 16384, SLABC = 2048;

constexpr size_t MiB = 1ull << 20;
constexpr size_t OFF_XC = 0;
constexpr size_t OFF_MOD = 16 * MiB;
constexpr size_t OFF_W = 17 * MiB;
constexpr size_t W0IN = 0, W0OUT = W0IN + (size_t)N0IN * 1024, UP0 = W0OUT + 1024 * 1024, DN0 = UP0 + (size_t)NUP * 1024,
                 W1IN = DN0 + (size_t)1024 * DFF, W1OUT = W1IN + (size_t)N1IN * 1024, UP1 = W1OUT + (size_t)1024 * 2048,
                 DN1 = UP1 + (size_t)NUP * 1024, WEND = DN1 + (size_t)1024 * DFF;
constexpr size_t OFF_H = 75 * MiB;
constexpr size_t OFF_BIG = 147 * MiB;
constexpr size_t OFF_P = OFF_BIG, OFF_F32 = OFF_BIG + 252 * MiB, OFF_R2 = OFF_BIG + 259 * MiB;
constexpr size_t OFF_U = OFF_BIG, OFF_ACT = OFF_BIG + 144 * MiB;
constexpr size_t OFF_XBC = OFF_BIG, OFF_Z = OFF_BIG + 108 * MiB, OFF_DT = OFF_BIG + 172 * MiB, OFF_XBCC = OFF_BIG + 177 * MiB, OFF_YF = OFF_BIG, OFF_YB = OFF_BIG + 285 * MiB;
constexpr size_t WS_NEED = OFF_BIG + 349 * MiB;
static_assert(WEND * 2 <= 58 * MiB, "weights region");

constexpr int LDS_BYTES = 144 * 1024;
constexpr int NPHASE = 36;

struct Params {
    const float* in[31];
    float* out;
    unsigned char* ws;
    int ph_lo, ph_hi;
};


#define GAS __attribute__((address_space(1)))
template <int OFF> DEVI const void* karg_ptr() { const GAS char* r; asm volatile("s_load_dwordx2 %0, %1, %2\n\ts_waitcnt lgkmcnt(0)" : "=s"(r) : "s"(__builtin_amdgcn_kernarg_segment_ptr()), "n"(OFF));
    return (const void*)r; }
#define INP(i) ((const float*)karg_ptr<(i) * 8>())
#define OUTP() ((float*)karg_ptr<31 * 8>())
#define WSP() ((unsigned char*)karg_ptr<32 * 8>())
template <int OFF> DEVI int karg_int() { int r; asm volatile("s_load_dword %0, %1, %2\n\ts_waitcnt lgkmcnt(0)" : "=s"(r) : "s"(__builtin_amdgcn_kernarg_segment_ptr()), "n"(OFF)); return r; }
#define PH_LO() karg_int<33 * 8>()
#define PH_HI() karg_int<33 * 8 + 4>()
DEVI int tid_l() { int t = threadIdx.x; asm volatile("" : "+v"(t)); return t; }
DEVI int bid_l() { int t = blockIdx.x; asm volatile("" : "+s"(t)); return t; }
DEVI bf16_t f2bf(float f) { unsigned u = __float_as_uint(f); u += 0x7FFFu + ((u >> 16) & 1u); return (bf16_t)(u >> 16); }
DEVI float bf2f(bf16_t b) { return __uint_as_float(((unsigned)b) << 16); }
typedef __bf16 bf16x2_t __attribute__((ext_vector_type(2)));
typedef float f32x2_t __attribute__((ext_vector_type(2)));
DEVI unsigned pack2(float a, float b) { const f32x2_t v = {a, b}; const bf16x2_t r = __builtin_convertvector(v, bf16x2_t); return __builtin_bit_cast(unsigned, r); }
DEVI uint2 pack4(f32x4 v) { uint2 r; r.x = pack2(v[0], v[1]); r.y = pack2(v[2], v[3]); return r; }
DEVI float silu_f(float v) { return v * __builtin_amdgcn_rcpf(1.f + __expf(-v)); }
DEVI float sigmoid_f(float v) { return __builtin_amdgcn_rcpf(1.f + __expf(-v)); }
DEVI float logsig_f(float x) { return fminf(x, 0.f) - __logf(1.f + __expf(-fabsf(x))); }
DEVI float softplus_f(float x) { return x > 20.f ? x : __logf(1.f + __expf(x)); }
DEVI float wave_sum(float v) {
#pragma unroll
    for (int o = 32; o >= 1; o >>= 1) v += __shfl_xor(v, o);
    return v;
}
DEVI bf16x8 ldsfrag(const bf16_t* base, int ld, int row, int k) { return *(const bf16x8*)(base + row * ld + k); }
DEVI f32x4 mfma16(bf16x8 a, bf16x8 b, f32x4 c) { return __builtin_amdgcn_mfma_f32_16x16x32_bf16(a, b, c, 0, 0, 0); }
DEVI void unpack8(bf16x8 v, float (&o)[8]) {
#pragma unroll
    for (int e = 0; e < 8; ++e) o[e] = bf2f((bf16_t)v[e]);
}
DEVI bf16x8 packf8(const float (&o)[8]) {
    typedef unsigned u32x4 __attribute__((ext_vector_type(4)));
    u32x4 r; r[0] = pack2(o[0], o[1]); r[1] = pack2(o[2], o[3]); r[2] = pack2(o[4], o[5]); r[3] = pack2(o[6], o[7]);
    return __builtin_bit_cast(bf16x8, r);
}
DEVI bf16_t f2bf1(float a) { return (bf16_t)(pack2(a, a) & 0xFFFFu); }
typedef short s16x4 __attribute__((ext_vector_type(4)));
template <int LD> DEVI bf16x8 tr_frag(const bf16_t* base, int s0, int c0, int l15, int lq) {
#ifdef TR_EMUL
    bf16x8 r;
#pragma unroll
    for (int e = 0; e < 8; ++e) r[e] = (short)base[(s0 + lq * 8 + e) * LD + c0 + l15];
    return r;
#else
    const bf16_t* a = base + (s0 + lq * 8 + (l15 >> 2)) * LD + c0 + 4 * (l15 & 3);
    const s16x4 lo = __builtin_amdgcn_ds_read_tr16_b64_v4i16((LAS s16x4*)a);
    const s16x4 hi = __builtin_amdgcn_ds_read_tr16_b64_v4i16((LAS s16x4*)(a + 4 * LD));
    return __builtin_shufflevector(lo, hi, 0, 1, 2, 3, 4, 5, 6, 7);
#endif
}
template <class WT> DEVI void conv2x8w(bf16x8 r0, bf16x8 r1, bf16x8 r2, bf16x8 r3, bool v0, bool v3, const WT& cw, bf16x8& o0, bf16x8& o1) {
    const bf16x8 zz = {0, 0, 0, 0, 0, 0, 0, 0};
    if (!v0) r0 = zz;
    if (!v3) r3 = zz;
    float a[8], b[8];
#pragma unroll
    for (int e = 0; e < 8; ++e) { const f32x4 w = cw[e];
        const float x0 = bf2f((bf16_t)r0[e]), x1 = bf2f((bf16_t)r1[e]), x2 = bf2f((bf16_t)r2[e]), x3 = bf2f((bf16_t)r3[e]);
        a[e] = silu_f(w[0] * x0 + w[1] * x1 + w[2] * x2 + w[3]); b[e] = silu_f(w[0] * x1 + w[1] * x2 + w[2] * x3 + w[3]); }
    o0 = packf8(a); o1 = packf8(b);
}
DEVI void conv2x8(bf16x8 r0, bf16x8 r1, bf16x8 r2, bf16x8 r3, bool v0, bool v3, const f32x4* cw, bf16x8& o0, bf16x8& o1) {
    const bf16x8 zz = {0, 0, 0, 0, 0, 0, 0, 0};
    if (!v0) r0 = zz;
    if (!v3) r3 = zz;
    float a[8], b[8];
#pragma unroll
    for (int e = 0; e < 8; ++e) { const f32x4 w = cw[e];
        const float x0 = bf2f((bf16_t)r0[e]), x1 = bf2f((bf16_t)r1[e]), x2 = bf2f((bf16_t)r2[e]), x3 = bf2f((bf16_t)r3[e]);
        a[e] = silu_f(w[0] * x0 + w[1] * x1 + w[2] * x2 + w[3]); b[e] = silu_f(w[0] * x1 + w[1] * x2 + w[2] * x3 + w[3]); }
    o0 = packf8(a); o1 = packf8(b);
}

namespace pg8 {
constexpr int BM = 256, BK = 64, HALF = 128, HTB = HALF * BK * 2, STAGE_BYTES = 8 * HTB, NXCD = 8, WGM = 8;
DEVI int lds_byte(int r, int c) { const int st = (r >> 4) * 2 + (c >> 5), rr = r & 15, cc = c & 31, ob = rr * 64 + cc * 2; return st * 1024 + (ob ^ (((ob >> 9) & 1) << 5)); }
DEVI void stage_rc(int b, int& R, int& C) { const int st = b / 1024, sb = b % 1024, swz = sb ^ (((sb >> 9) & 1) << 5); R = (st >> 1) * 16 + swz / 64; C = (st & 1) * 32 + (swz % 64) / 2; }
struct Unit { int pm, pn; };
struct Gemm { const bf16_t* A; const bf16_t* Bt; int M, N, K; int split, off0, off1; };
struct StaticOrder {
    int nM, nN, nwg, G, c;
    DEVI void init(int M, int N, int G_, int c_) { nM = M / BM; nN = N / BM; nwg = nM * nN; G = G_; c = c_; }
    DEVI bool next(int i, Unit& u) const {
        const long L = (long)i * G + c; if (L >= nwg) return false;
        int wgid = (int)L; { const int q = nwg / NXCD, r = nwg % NXCD, xcd = wgid % NXCD, off = wgid / NXCD; wgid = (xcd < r ? xcd * (q + 1) : r * (q + 1) + (xcd - r) * q) + off; }
        const int nig = WGM * nN, gid = wgid / nig, fm = gid * WGM, gsz = (nM - fm) < WGM ? (nM - fm) : WGM;
        u.pm = fm + ((wgid % nig) % gsz); u.pn = (wgid % nig) / gsz; return true;
    }
};

template <class Epi>
DEVI void gemm_phase(LAS unsigned char* lds, const Gemm g, const StaticOrder& S, const Epi& E) {
    const int tid = tid_l(), wid = __builtin_amdgcn_readfirstlane(tid >> 6), lane = tid & 63, wr = wid >> 2, wc = wid & 3, fr = lane & 15, fq = lane >> 4;
    const int K = g.K, nt = K / BK;
    unsigned voffA[2];
#pragma unroll
    for (int i = 0; i < 2; ++i) { int R, C; stage_rc(tid * 16 + i * 8192, R, C); voffA[i] = (unsigned)(R * K + C) * 2u; }
    const size_t kstep = (size_t)(BK * 2);
    const size_t hstep = (size_t)HALF * K * 2;
    const size_t tstep = 2 * hstep;
    const unsigned ldsw = (unsigned)wid * 1024u;
    const int aoff = lds_byte(wr * 64 + fr, fq * 8), boff = lds_byte(wc * 32 + fr, fq * 8);
#define PG8_SA(b, h) (((b) * 2 + (h)) * HTB)
#define PG8_SB(b, h) ((4 + (b) * 2 + (h)) * HTB)
#define PG8_STAGE(bufoff, gbase) do { _Pragma("unroll") for (int _i = 0; _i < 2; ++_i) \
        __builtin_amdgcn_global_load_lds((const unsigned*)((const char*)(gbase) + voffA[_i]), (LAS unsigned*)(lds + (bufoff) + ldsw + _i * 8192), 16, 0, 0); } while (0)
#define PG8_LDA(dst, b, h) do { _Pragma("unroll") for (int m = 0; m < 4; ++m) _Pragma("unroll") for (int k = 0; k < 2; ++k) dst[m][k] = *(const LAS bf16x8*)(lds + PG8_SA(b, h) + aoff + m * 2048 + k * 1024); } while (0)
#define PG8_LDB(dst, b, h) do { _Pragma("unroll") for (int n = 0; n < 2; ++n) _Pragma("unroll") for (int k = 0; k < 2; ++k) dst[n][k] = *(const LAS bf16x8*)(lds + PG8_SB(b, h) + boff + n * 2048 + k * 1024); } while (0)
#define PG8_MMA(ai, bj, At, Bt) do { __builtin_amdgcn_s_setprio(1); _Pragma("unroll") for (int m = 0; m < 4; ++m) _Pragma("unroll") for (int n = 0; n < 2; ++n) _Pragma("unroll") for (int k = 0; k < 2; ++k) \
        acc[ai][bj][m][n] = __builtin_amdgcn_mfma_f32_16x16x32_bf16(Bt[n][k], At[m][k], acc[ai][bj][m][n], 0, 0, 0); __builtin_amdgcn_s_setprio(0); } while (0)
#define PG8_WAIT_V(n) asm volatile("s_waitcnt vmcnt(" #n ")" ::: "memory")
#define PG8_WAIT_L(n) asm volatile("s_waitcnt lgkmcnt(" #n ")" ::: "memory")
#define PG8_BAR __builtin_amdgcn_s_barrier()
#define PG8_SCHED __builtin_amdgcn_sched_barrier(0)
#define PG8_PHYS(pm) ((pm) < g.split ? (pm) + g.off0 : (pm) - g.split + g.off1)
    Unit cur, nxt; int ui = 0;
    if (!S.next(0, cur)) return;
    f32x4 acc[2][2][4][2];
#pragma unroll
    for (int a = 0; a < 2; ++a)
#pragma unroll
        for (int b = 0; b < 2; ++b)
#pragma unroll
            for (int m = 0; m < 4; ++m)
#pragma unroll
                for (int n = 0; n < 2; ++n) acc[a][b][m][n] = (f32x4){0.f, 0.f, 0.f, 0.f};
    bf16x8 At[4][2], B0[2][2], B1[2][2];
    const char* cA = (const char*)g.A + (size_t)PG8_PHYS(cur.pm) * tstep; const char* cB = (const char*)g.Bt + (size_t)cur.pn * tstep;
    PG8_STAGE(PG8_SB(0, 0), cB); PG8_STAGE(PG8_SA(0, 0), cA); PG8_STAGE(PG8_SB(0, 1), cB + hstep); PG8_STAGE(PG8_SA(0, 1), cA + hstep);
    if (wr == 1) PG8_BAR;
    PG8_WAIT_V(4); PG8_BAR;
    PG8_STAGE(PG8_SB(1, 0), cB + kstep); PG8_STAGE(PG8_SA(1, 0), cA + kstep); PG8_STAGE(PG8_SB(1, 1), cB + hstep + kstep);
    PG8_WAIT_V(6); PG8_BAR;
    for (;;) {
        const bool has_next = S.next(ui + 1, nxt);
        const char* nA = has_next ? (const char*)g.A + (size_t)PG8_PHYS(nxt.pm) * tstep : cA; const char* nB = has_next ? (const char*)g.Bt + (size_t)nxt.pn * tstep : cB;
        for (int t = 0; t < nt; t += 2) {
            const bool last = (t == nt - 2);
            const char* a1 = cA + (size_t)(t + 1) * kstep;
            const char* a2 = last ? nA : cA + (size_t)(t + 2) * kstep; const char* b2 = last ? nB : cB + (size_t)(t + 2) * kstep;
            const char* a3 = a2 + kstep; const char* b3 = b2 + kstep;
            PG8_LDB(B0, 0, 0); PG8_SCHED; PG8_LDA(At, 0, 0); PG8_STAGE(PG8_SA(1, 1), a1 + hstep);
            PG8_WAIT_L(8); PG8_BAR; PG8_WAIT_L(0); PG8_MMA(0, 0, At, B0); PG8_BAR; PG8_SCHED;
            PG8_LDB(B1, 0, 1); PG8_STAGE(PG8_SB(0, 0), b2);
            PG8_BAR; PG8_WAIT_L(0); PG8_MMA(0, 1, At, B1); PG8_BAR;
            PG8_LDA(At, 0, 1); PG8_STAGE(PG8_SA(0, 0), a2);
            PG8_BAR; PG8_WAIT_L(0); PG8_MMA(1, 0, At, B0); PG8_BAR; PG8_SCHED;
            PG8_STAGE(PG8_SB(0, 1), b2 + hstep);
            PG8_WAIT_V(6); PG8_BAR; PG8_MMA(1, 1, At, B1); PG8_BAR;
            PG8_LDB(B0, 1, 0); PG8_SCHED; PG8_LDA(At, 1, 0); PG8_STAGE(PG8_SA(0, 1), a2 + hstep);
            PG8_WAIT_L(8); PG8_BAR; PG8_WAIT_L(0); PG8_MMA(0, 0, At, B0); PG8_BAR; PG8_SCHED;
            PG8_LDB(B1, 1, 1); PG8_STAGE(PG8_SB(1, 0), b3);
            PG8_BAR; PG8_WAIT_L(0); PG8_MMA(0, 1, At, B1); PG8_BAR;
            PG8_LDA(At, 1, 1); PG8_STAGE(PG8_SA(1, 0), a3);
            PG8_BAR; PG8_WAIT_L(0); PG8_MMA(1, 0, At, B0); PG8_BAR; PG8_SCHED;
            PG8_STAGE(PG8_SB(1, 1), b3 + hstep);
            PG8_WAIT_V(6); PG8_BAR; PG8_MMA(1, 1, At, B1); PG8_BAR;
        }
        { int tid2 = tid_l(); const int wid2 = tid2 >> 6, lane2 = tid2 & 63; E(acc, cur, wid2 >> 2, wid2 & 3, lane2 & 15, lane2 >> 4); }
        if (!has_next) break;
#pragma unroll
        for (int a = 0; a < 2; ++a)
#pragma unroll
            for (int b = 0; b < 2; ++b)
#pragma unroll
                for (int m = 0; m < 4; ++m)
#pragma unroll
                    for (int n = 0; n < 2; ++n) acc[a][b][m][n] = (f32x4){0.f, 0.f, 0.f, 0.f};
        cur = nxt; cA = nA; cB = nB; ++ui;
    }
    PG8_WAIT_V(0);
    if (wr == 0) PG8_BAR;
    PG8_BAR;
#undef PG8_SA
#undef PG8_SB
#undef PG8_STAGE
#undef PG8_LDA
#undef PG8_LDB
#undef PG8_MMA
#undef PG8_WAIT_V
#undef PG8_WAIT_L
#undef PG8_BAR
#undef PG8_SCHED
#undef PG8_PHYS
}
}
using pg8::Unit;

struct EpiBf16 {
    bf16_t* O; int ldc;
    DEVI void operator()(const f32x4 (&acc)[2][2][4][2], const Unit& u, int wr, int wc, int fr, int fq) const {
        const int row0 = u.pm * 256 + wr * 64 + fr, col0 = u.pn * 256 + wc * 32 + 8 * fq;
#pragma unroll
        for (int ai = 0; ai < 2; ++ai)
#pragma unroll
            for (int m = 0; m < 4; ++m) { bf16_t* rowp = O + (size_t)(row0 + ai * 128 + m * 16) * ldc + col0;
#pragma unroll
                for (int bj = 0; bj < 2; ++bj) { const uint2 a = pack4(acc[ai][bj][m][0]), b = pack4(acc[ai][bj][m][1]);
                    *(uint4*)(rowp + bj * 128) = make_uint4(a.x, a.y, b.x, b.y); } }
    }
};
struct EpiInL0 {
    bf16_t* P; float* F; bf16_t* R2raw;
    DEVI void operator()(const f32x4 (&acc)[2][2][4][2], const Unit& u, int wr, int wc, int fr, int fq) const {
        const int row0 = u.pm * 256 + wr * 64 + fr;
        if (u.pn >= 6 && u.pn < 10) { EpiBf16 e{R2raw, 1024}; Unit v = u; v.pn -= 6; e(acc, v, wr, wc, fr, fq); return; }
        if (u.pn < 14) { EpiBf16 e{P, PLD}; e(acc, u, wr, wc, fr, fq); return; }
        const int c0 = wc * 32 + 4 * fq;
#pragma unroll
        for (int ai = 0; ai < 2; ++ai)
#pragma unroll
            for (int m = 0; m < 4; ++m) { float* rowp = F + (size_t)(row0 + ai * 128 + m * 16) * FLD;
#pragma unroll
                for (int n = 0; n < 2; ++n) { const int c = c0 + n * 16; if (c < 48) *(f32x4*)(rowp + c) = acc[ai][0][m][n]; } }
    }
};
struct EpiInL1 {
    bf16_t* X; bf16_t* Z; float* DT;
    DEVI void operator()(const f32x4 (&acc)[2][2][4][2], const Unit& u, int wr, int wc, int fr, int fq) const {
        if (u.pn < 12) { EpiBf16 e{X, 3072}; e(acc, u, wr, wc, fr, fq); return; }
        if (u.pn < 20) { if (u.pm < 64) { EpiBf16 e{Z, 2048}; Unit v = u; v.pn -= 12; e(acc, v, wr, wc, fr, fq); } return; }
        const int row0 = u.pm * 256 + wr * 64 + fr, c0 = wc * 32 + 4 * fq;
#pragma unroll
        for (int ai = 0; ai < 2; ++ai)
#pragma unroll
            for (int m = 0; m < 4; ++m) { float* rowp = DT + (size_t)(row0 + ai * 128 + m * 16) * 64;
#pragma unroll
                for (int n = 0; n < 2; ++n) { const int c = c0 + n * 16; if (c < 64) *(f32x4*)(rowp + c) = acc[ai][0][m][n]; } }
    }
};
struct EpiResid {
    float* XL; float* XC; const float* mod; int goff; int rowbase;
    DEVI void operator()(const f32x4 (&acc)[2][2][4][2], const Unit& u, int wr, int wc, int fr, int fq) const {
        const int grow_t = __builtin_amdgcn_readfirstlane(rowbase + u.pm * 256);
        const bool isc = grow_t >= MLAT;
        const int bidx = isc ? 16 : (grow_t >> 11);
        float* X = isc ? XC + (size_t)(grow_t - MLAT) * DM : XL + (size_t)grow_t * DM;
        const float* gate = mod + (size_t)bidx * 6144 + goff + u.pn * 256;
        X += u.pn * 256;
        const unsigned r0 = wr * 64 + fr, c0 = wc * 32 + 8 * fq;
        f32x4 gv[2][2];
#pragma unroll
        for (int bj = 0; bj < 2; ++bj)
#pragma unroll
            for (int n = 0; n < 2; ++n) gv[bj][n] = *(const f32x4*)(gate + c0 + bj * 128 + n * 4);
#pragma unroll
        for (int ai = 0; ai < 2; ++ai) {
            f32x4 rv[4][2][2];
#pragma unroll
            for (int m = 0; m < 4; ++m) { const unsigned ro = (r0 + ai * 128 + m * 16) * DM + c0;
#pragma unroll
                for (int bj = 0; bj < 2; ++bj)
#pragma unroll
                    for (int n = 0; n < 2; ++n) rv[m][bj][n] = *(const f32x4*)(X + ro + bj * 128 + n * 4); }
#pragma unroll
            for (int m = 0; m < 4; ++m) { const unsigned ro = (r0 + ai * 128 + m * 16) * DM + c0;
#pragma unroll
                for (int bj = 0; bj < 2; ++bj)
#pragma unroll
                    for (int n = 0; n < 2; ++n) *(f32x4*)(X + ro + bj * 128 + n * 4) = rv[m][bj][n] + gv[bj][n] * acc[ai][bj][m][n]; }
            __builtin_amdgcn_sched_barrier(0); }
    }
};

template <class Epi>
DEVI void run_gemm(unsigned char* shm, const bf16_t* A, const bf16_t* Bt, int M, int N, int K, const Epi& E, int split = 1 << 30, int off0 = 0, int off1 = 0, int nblk = 0) {
    pg8::Gemm g{A, Bt, M, N, K, split, off0, off1};
    pg8::StaticOrder S; S.init(M, N, nblk ? nblk : (int)gridDim.x, (int)bid_l());
    pg8::gemm_phase<Epi>((LAS unsigned char*)shm, g, S, E);
}

DEVI int perm32(int rho) { const int n = rho >> 4, i = rho & 15; return 8 * (i >> 2) + 4 * n + (i & 3); }
DEVI void wsrc_col(const Params& p, int m, int n, const float*& ptr, long& stride) {
    ptr = nullptr; stride = 0;
    if ((m == 0 && n < 3584) || m == 2 || m == 6 || (m == 4 && n < 5120) || m == 1 || m == 3 || m == 5 || m == 7) n = (n & ~31) + perm32(n & 31);
    switch (m) {
    case 0: if (n < 3600) { ptr = INP(13) + n; stride = 3600; } else if (n < 3632) { const int d = (n - 3600) >> 4, r = (n - 3600) & 15; ptr = INP(14) + d * 16384 + r; stride = 16; } break;
    case 1: ptr = INP(22) + n; stride = 1024; break;
    case 2: case 6: { const int g = n < 2048 ? 0 : (n < 4096 ? 1 : 2); const int base = g * 2048, w = g == 2 ? 768 : 1024, j0 = g * 1024, o = n - base;
        const int col = o < w ? j0 + o : 2816 + j0 + (o - w); ptr = INP(9) + (size_t)(m == 6 ? 1 : 0) * 1024 * NUP + col; stride = NUP; } break;
    case 3: case 7: ptr = INP(12) + (size_t)(m == 7 ? 1 : 0) * DFF * 1024 + n; stride = 1024; break;
    case 4: if (n < 5184) { const int col = n < 3072 ? 2048 + n : (n < 5120 ? n - 3072 : n); ptr = INP(23) + col; stride = 5184; } break;
    case 5: ptr = INP(30) + n; stride = 1024; break;
    }
}
DEVI void phase_prep(const Params& p, unsigned char* shm) {
    bf16_t* Wb = (bf16_t*)(WSP() + OFF_W);
    float* tile = (float*)shm;
    const int tid = tid_l();
    const int nbk[8] = {60 * 4, 16 * 4, 88 * 4, 16 * 11, 84 * 4, 16 * 8, 88 * 4, 16 * 11};
    const int kb_[8] = {4, 4, 4, 11, 4, 8, 4, 11};
    const size_t woff[8] = {W0IN, W0OUT, UP0, DN0, W1IN, W1OUT, UP1, DN1};
    int total = 0;
#pragma unroll
    for (int i = 0; i < 8; ++i) total += nbk[i];
    for (int u = bid_l(); u < total; u += gridDim.x) {
        int m = 0, r = u;
#pragma unroll
        for (int i = 0; i < 8; ++i) { if (m == i && r >= nbk[i]) { r -= nbk[i]; m = i + 1; } }
        int kbn = 4; size_t wo = 0;
#pragma unroll
        for (int i = 0; i < 8; ++i) if (m == i) { kbn = kb_[i]; wo = woff[i]; }
        const int nblk = r / kbn, kblk = r % kbn, K = kbn * 256;
        const int n0 = nblk * 64, k0 = kblk * 256;
        const float* cp; long cs; wsrc_col(p, m, n0 + (tid & 63), cp, cs);
        __syncthreads();
        float ld_[32];
#pragma unroll
        for (int i = 0; i < 32; ++i) { const int k = i * 8 + (tid >> 6); ld_[i] = cp ? cp[(size_t)(k0 + k) * cs] : 0.f; }
#pragma unroll
        for (int i = 0; i < 32; ++i) { const int k = i * 8 + (tid >> 6); tile[k * 65 + (tid & 63)] = ld_[i]; }
        __syncthreads();
#pragma unroll
        for (int q = 0; q < 4; ++q) { const int n = tid >> 3, kq = q * 64 + (tid & 7) * 8; float v[8];
#pragma unroll
          for (int e = 0; e < 8; ++e) v[e] = tile[(kq + e) * 65 + n];
          *(bf16x8*)(Wb + wo + (size_t)(n0 + n) * K + k0 + kq) = packf8(v); }
    }
    __syncthreads();
    float* sc = (float*)shm;
    float* red = sc + 17 * 1024;
    const int nmu = 2 * 192;
    if ((int)bid_l() < nmu) {
        for (int i = tid; i < 17 * 1024; i += 512) { const int v = i >> 10, k = i & 1023; const float c = v < 16 ? INP(1)[v * 1024 + k] : INP(3)[k]; sc[i] = silu_f(c); }
        __syncthreads();
        float* MOD = (float*)(WSP() + OFF_MOD);
        for (int u = bid_l(); u < nmu; u += gridDim.x) {
            const int layer = u / 192, cb = (u % 192) * 32, col = tid & 31, kg = tid >> 5;
            const float* w = INP(4) + (size_t)layer * 1024 * 6144 + cb + col;
            float a[17];
#pragma unroll
            for (int v = 0; v < 17; ++v) a[v] = 0.f;
            for (int k0 = kg * 64; k0 < kg * 64 + 64; k0 += 16) { float wv[16];
#pragma unroll
                for (int q = 0; q < 16; ++q) wv[q] = w[(size_t)(k0 + q) * 6144];
#pragma unroll
                for (int q = 0; q < 16; ++q) {
#pragma unroll
                    for (int v = 0; v < 17; ++v) a[v] += sc[v * 1024 + k0 + q] * wv[q]; } }
#pragma unroll
            for (int v = 0; v < 17; ++v) red[(kg * 17 + v) * 32 + col] = a[v];
            __syncthreads();
            for (int i = tid; i < 17 * 32; i += 512) { const int v = i >> 5, c = i & 31; float s = INP(5)[layer * 6144 + cb + c];
#pragma unroll
                for (int q = 0; q < 16; ++q) s += red[(q * 17 + v) * 32 + c];
                MOD[((size_t)layer * 17 + v) * 6144 + cb + c] = s; }
            __syncthreads();
        }
    }
}

DEVI void phase_modulate(const Params& p, const float* srcL, const float* srcC, int nrows, const float* g, int layer, int soff, float* cpL = nullptr, float* cpC = nullptr, int rbeg = 0, int b0 = 0) {
    const int tid_ = tid_l(); const int wid = tid_ >> 6, lane = tid_ & 63;
    bf16_t* H = (bf16_t*)(WSP() + OFF_H);
    const float* MOD = (const float*)(WSP() + OFF_MOD) + (size_t)layer * 17 * 6144;
    const int nw = ((int)gridDim.x - b0) * 8, rpw = (nrows - rbeg + nw - 1) / nw;
    if ((int)bid_l() < b0) return;
    int row = rbeg + ((bid_l() - b0) * 8 + wid) * rpw;
    const int rend = min(row + rpw, nrows);
    f32x4 v[4], nv[4], gs[4], sh[4];
#pragma unroll
    for (int i = 0; i < 4; ++i) { gs[i] = (f32x4){0.f, 0.f, 0.f, 0.f}; sh[i] = gs[i]; }
    int cur_b = -1;
    auto loadrow = [&](int r, f32x4 (&d)[4]) { const bool isc = r >= MLAT; const float* src = isc ? srcC + (size_t)(r - MLAT) * DM : srcL + (size_t)r * DM;
#pragma unroll
        for (int i = 0; i < 4; ++i) d[i] = *(const f32x4*)(src + i * 256 + lane * 4); };
    if (row < rend) loadrow(row, v);
    for (; row < rend; ++row) {
        const bool isc = row >= MLAT;
        if (row + 1 < rend) loadrow(row + 1, nv);
        const int b = isc ? 16 : (row >> 11);
        if (b != cur_b) { cur_b = b; const float* md = MOD + (size_t)b * 6144 + soff;
#pragma unroll
            for (int i = 0; i < 4; ++i) { const int c = i * 256 + lane * 4; const f32x4 gg = *(const f32x4*)(g + c), sc = *(const f32x4*)(md + 1024 + c); sh[i] = *(const f32x4*)(md + c); gs[i] = gg * (sc + 1.f); } }
        float ss = 0.f;
#pragma unroll
        for (int i = 0; i < 4; ++i) ss += v[i][0] * v[i][0] + v[i][1] * v[i][1] + v[i][2] * v[i][2] + v[i][3] * v[i][3];
        ss = wave_sum(ss);
        if (cpL) { float* cp = isc ? cpC + (size_t)(row - MLAT) * DM : cpL + (size_t)row * DM;
#pragma unroll
            for (int i = 0; i < 4; ++i) *(f32x4*)(cp + i * 256 + lane * 4) = v[i]; }
        const float rstd = rsqrtf(ss * (1.f / 1024.f) + 1e-6f);
#pragma unroll
        for (int i = 0; i < 4; ++i) { const int c = i * 256 + lane * 4;
            *(uint2*)(H + (size_t)row * DM + c) = pack4(v[i] * rstd * gs[i] + sh[i]); }
#pragma unroll
        for (int i = 0; i < 4; ++i) v[i] = nv[i];
    }
}
DEVI void phase_final_norm(const Params& p) {
    const int tid_ = tid_l(); const int wid = tid_ >> 6, lane = tid_ & 63;
    const float* g = INP(8);
    float* X = OUTP();
    const int stride = gridDim.x * 8;
    int row = bid_l() * 8 + wid;
    f32x4 v[4], nv[4], gg[4];
#pragma unroll
    for (int i = 0; i < 4; ++i) gg[i] = *(const f32x4*)(g + i * 256 + lane * 4);
    if (row < MLAT) {
#pragma unroll
        for (int i = 0; i < 4; ++i) v[i] = *(const f32x4*)(X + (size_t)row * DM + i * 256 + lane * 4); }
    for (; row < MLAT; row += stride) {
        if (row + stride < MLAT) {
#pragma unroll
            for (int i = 0; i < 4; ++i) nv[i] = *(const f32x4*)(X + (size_t)(row + stride) * DM + i * 256 + lane * 4); }
        float ss = 0.f;
#pragma unroll
        for (int i = 0; i < 4; ++i) ss += v[i][0] * v[i][0] + v[i][1] * v[i][1] + v[i][2] * v[i][2] + v[i][3] * v[i][3];
        ss = wave_sum(ss);
        const float rstd = rsqrtf(ss * (1.f / 1024.f) + 1e-6f);
#pragma unroll
        for (int i = 0; i < 4; ++i) *(f32x4*)(X + (size_t)row * DM + i * 256 + lane * 4) = v[i] * rstd * gg[i];
#pragma unroll
        for (int i = 0; i < 4; ++i) v[i] = nv[i];
    }
}

template <int N>
DEVI void conv_silu(const bf16_t* src, int ld, int pos0, int seqlen, float w0, float w1, float w2, float bias, float (&out)[N]) {
    const bool has_prev = pos0 >= 1, has_next = pos0 + N < seqlen;
    bf16_t raw[N + 2];
    raw[0] = src[has_prev ? -(long)ld : 0];
#pragma unroll
    for (int i = 0; i < N; ++i) raw[i + 1] = src[(size_t)i * ld];
    raw[N + 1] = src[(size_t)(has_next ? N : N - 1) * ld];
    float prev = has_prev ? bf2f(raw[0]) : 0.f;
    float cur = bf2f(raw[1]);
#pragma unroll
    for (int i = 0; i < N; ++i) {
        const float nxt = (i + 1 < N) ? bf2f(raw[i + 2]) : (has_next ? bf2f(raw[N + 1]) : 0.f);
        out[i] = silu_f(w0 * prev + w1 * cur + w2 * nxt + bias);
        prev = cur; cur = nxt;
    }
}
template <int N>
DEVI void store_row_t(bf16_t* dst, const float (&v)[N]) {
#pragma unroll
    for (int q = 0; q < N / 8; ++q) { bf16x8 r;
#pragma unroll
        for (int e = 0; e < 8; ++e) r[e] = (short)f2bf(v[q * 8 + e]);
        *(bf16x8*)(dst + q * 8) = r; }
}
DEVI void chain_chunk(int b, int dir, int step, int& row0, int& pos0, int& seqlen, bool& is_ctx) {
    if (step < 4) { const int c = dir ? 3 - step : step; is_ctx = true; pos0 = c * 64; seqlen = TC; row0 = MLAT + b * TC + pos0; }
    else { const int c = dir ? 31 - (step - 4) : (step - 4); is_ctx = false; pos0 = c * 64; seqlen = TL; row0 = b * TL + pos0; }
}

DEVI void gla_chain(const Params& p, int b, int h, int dir, unsigned char* shm) {
    bf16_t* sQ = (bf16_t*)shm;
    bf16_t* sK = sQ + 64 * 72;
    bf16_t* sKe = sK + 64 * 72;
    bf16_t* sVt = sKe + 64 * 72;
    bf16_t* sAt = sVt + 128 * 72;
    bf16_t* sSt = sAt + 64 * 72;
    float* sSeg = (float*)(sSt + 128 * 72);
    float* sR = sSeg + 8 * 64;
    float* sDec = sR + 64 * 16;
    const int tid = tid_l(), wid = tid >> 6, lane = tid & 63, l15 = lane & 15, lq = lane >> 4;
    const bf16_t* P = (const bf16_t*)(WSP() + OFF_P);
    const float* F = (const float*)(WSP() + OFF_F32);
    bf16_t* R1 = (bf16_t*)(WSP() + OFF_H);
    const int k = lane, tg = wid;
    float a2v[16];
#pragma unroll
    for (int r = 0; r < 16; ++r) a2v[r] = INP(15)[(dir * 16 + r) * 256 + h * 64 + k];
    const float abv = INP(16)[dir * 256 + h * 64 + k];
    f32x4 S[4];
#pragma unroll
    for (int i = 0; i < 4; ++i) S[i] = (f32x4){0.f, 0.f, 0.f, 0.f};
    __syncthreads();
    for (int i = tid; i < 128 * 72 / 2; i += 512) ((unsigned*)sSt)[i] = 0u;
    bf16_t qraw[8], kraw[8], vraw[16]; float2 rr;
    auto issue = [&](int step) {
        int row0, pos0, seqlen; bool ic; chain_chunk(b, dir, step, row0, pos0, seqlen, ic);
        { const int idx = tid * 2, t = idx >> 4, r = idx & 15; rr = *(const float2*)(F + (size_t)(row0 + t) * FLD + 16 + dir * 16 + r); }
#pragma unroll
        for (int j = 0; j < 8; ++j) { const int t = tg * 8 + j; qraw[j] = P[(size_t)(row0 + t) * PLD + h * 64 + k]; kraw[j] = P[(size_t)(row0 + t) * PLD + 256 + h * 64 + k]; }
        { const int v = tid & 127, tq = tid >> 7;
#pragma unroll
          for (int j = 0; j < 16; ++j) vraw[j] = P[(size_t)(row0 + tq * 16 + j) * PLD + 512 + h * 128 + v]; } };
    issue(0);
    { const int idx = tid * 2, t = idx >> 4, r = idx & 15; sR[t * 16 + r] = rr.x; sR[t * 16 + r + 1] = rr.y; }
    __syncthreads();
    for (int step = 0; step < 36; ++step) {
        int row0, pos0, seqlen; bool is_ctx; chain_chunk(b, dir, step, row0, pos0, seqlen, is_ctx);
        float cl[8];
        {
            float la[8];
#pragma unroll
            for (int j = 0; j < 8; ++j) { const int t = tg * 8 + j; float x = abv;
#pragma unroll
                for (int r = 0; r < 16; ++r) x += sR[t * 16 + r] * a2v[r];
                la[j] = logsig_f(x) * (1.f / 16.f); }
            if (!dir) { float s = 0.f;
#pragma unroll
                for (int j = 0; j < 8; ++j) { s += la[j]; cl[j] = s; }
                sSeg[tg * 64 + k] = s; }
            else { float s = 0.f;
#pragma unroll
                for (int j = 7; j >= 0; --j) { s += la[j]; cl[j] = s; }
                sSeg[tg * 64 + k] = s; }
        }
        __syncthreads();
        {
            float off = 0.f, tot = 0.f;
#pragma unroll
            for (int q = 0; q < 8; ++q) { const float sv = sSeg[q * 64 + k]; tot += sv; if (dir ? (q > tg) : (q < tg)) off += sv; }
            if (tg == 0) sDec[k] = __expf(tot);
            float ke[8];
#pragma unroll
            for (int j = 0; j < 8; ++j) { const int t = tg * 8 + j; const float cum = cl[j] + off;
                const float qv = bf2f(qraw[j]), kv = bf2f(kraw[j]);
                sQ[t * 72 + k] = f2bf1(qv * __expf(cum) * 0.125f);
                sK[t * 72 + k] = f2bf1(kv * __expf(-cum));
                ke[j] = kv * __expf(tot - cum); }
            store_row_t<8>(sKe + k * 72 + tg * 8, ke);
            const int v = tid & 127, tq = tid >> 7; float vv[16];
#pragma unroll
            for (int j = 0; j < 16; ++j) vv[j] = bf2f(vraw[j]);
            store_row_t<16>(sVt + v * 72 + tq * 16, vv);
            if (step + 1 < 36) issue(step + 1);
        }
        __syncthreads();
        { const int tm = wid >> 1;
#pragma unroll
          for (int q = 0; q < 2; ++q) { const int tn = (wid & 1) * 2 + q; f32x4 acc = (f32x4){0.f, 0.f, 0.f, 0.f};
#pragma unroll
              for (int kk = 0; kk < 64; kk += 32) acc = mfma16(ldsfrag(sQ, 72, tm * 16 + l15, kk + lq * 8), ldsfrag(sK, 72, tn * 16 + l15, kk + lq * 8), acc);
              const int s = tn * 16 + l15;
#pragma unroll
              for (int r = 0; r < 4; ++r) { const int t = tm * 16 + lq * 4 + r; const bool keep = dir ? (s >= t) : (s <= t); sAt[t * 72 + s] = f2bf1(keep ? acc[r] : 0.f); } } }
        __syncthreads();
#pragma unroll
        for (int tm = 0; tm < 4; ++tm) { f32x4 acc = (f32x4){0.f, 0.f, 0.f, 0.f};
#pragma unroll
            for (int kk = 0; kk < 64; kk += 32) acc = mfma16(ldsfrag(sAt, 72, tm * 16 + l15, kk + lq * 8), ldsfrag(sVt, 72, wid * 16 + l15, kk + lq * 8), acc);
#pragma unroll
            for (int kk = 0; kk < 64; kk += 32) acc = mfma16(ldsfrag(sQ, 72, tm * 16 + l15, kk + lq * 8), ldsfrag(sSt, 72, wid * 16 + l15, kk + lq * 8), acc);
#pragma unroll
            for (int r = 0; r < 4; ++r) { const int t = tm * 16 + lq * 4 + r; R1[(size_t)(row0 + t) * 1024 + dir * 512 + h * 128 + wid * 16 + l15] = f2bf1(acc[r]); } }
#pragma unroll
        for (int kb = 0; kb < 4; ++kb) {
#pragma unroll
            for (int r = 0; r < 4; ++r) S[kb][r] *= sDec[kb * 16 + lq * 4 + r];
#pragma unroll
            for (int kk = 0; kk < 64; kk += 32) S[kb] = mfma16(ldsfrag(sKe, 72, kb * 16 + l15, kk + lq * 8), ldsfrag(sVt, 72, wid * 16 + l15, kk + lq * 8), S[kb]);
            *(uint2*)(sSt + (wid * 16 + l15) * 72 + kb * 16 + lq * 4) = pack4(S[kb]); }
        if (step + 1 < 36) { const int idx = tid * 2, t = idx >> 4, r = idx & 15; sR[t * 16 + r] = rr.x; sR[t * 16 + r + 1] = rr.y; }
        __syncthreads();
    }
}

DEVI void phase_ml_conv(const Params& p, unsigned char* shm) {
    f32x4* sCwAll = (f32x4*)shm;
    const int tid = tid_l();
    const bf16_t* RAW = (const bf16_t*)(WSP() + OFF_R2);
    bf16_t* P = (bf16_t*)(WSP() + OFF_P);
    { const float* cw = INP(17); const float* cb = INP(18);
      for (int i = tid; i < 1024; i += 512) sCwAll[i] = (f32x4){cw[i], cw[1024 + i], cw[2048 + i], cb[i]}; }
    __syncthreads();
    const int ntask = (MTOT / 2) * 128;
    for (int i = bid_l() * 512 + tid; i < ntask; i += gridDim.x * 512) {
        const int v = i & 127, pr = i >> 7, r0 = pr * 2;
        int pos, seqlen;
        if (r0 < MLAT) { pos = r0 & (TL - 1); seqlen = TL; } else { pos = (r0 - MLAT) & (TC - 1); seqlen = TC; }
        const bool v0 = pos >= 1, v3 = pos + 2 < seqlen;
        const bf16_t* base = RAW + (size_t)r0 * 1024 + v * 8;
        const long om = v0 ? -1024l : 0l, o3 = v3 ? 2048l : 1024l;
        const bf16x8 a0 = *(const bf16x8*)(base + om), a1 = *(const bf16x8*)(base), a2 = *(const bf16x8*)(base + 1024), a3 = *(const bf16x8*)(base + o3);
        bf16x8 oa, ob; conv2x8(a0, a1, a2, a3, v0, v3, sCwAll + v * 8, oa, ob);
        if (v >= 64) { float x[8], y[8]; unpack8(oa, x); unpack8(ob, y);
#pragma unroll
            for (int e = 0; e < 8; ++e) { x[e] *= 0.08838834764831845f; y[e] *= 0.08838834764831845f; }
            oa = packf8(x); ob = packf8(y); }
        *(bf16x8*)(P + (size_t)r0 * PLD + 1536 + v * 8) = oa; *(bf16x8*)(P + (size_t)(r0 + 1) * PLD + 1536 + v * 8) = ob;
    }
}

DEVI void mlstm_chain(const Params& p, int b, int h, int dir, unsigned char* shm) {
    bf16_t* sQ = (bf16_t*)shm;
    bf16_t* sK = sQ + 64 * 136;
    bf16_t* sV = sK + 64 * 136;
    bf16_t* sH = sV + 64 * 136;
    bf16_t* sSc = sH + 64 * 136;
    bf16_t* sCt = sSc + 64 * 72;
    float* sRow = (float*)(sCt + 144 * 136);
    float* sU = sRow + 64;
    float* sAw = sU + 64;
    float* sWs = sAw + 64;
    float* sEmt = sWs + 64;
    float* sDen = sEmt + 64;
    float* sScal = sDen + 64;
    f32x4* sCw = (f32x4*)(sScal + 4);
    const int tid = tid_l(), wid = tid >> 6, lane = tid & 63, l15 = lane & 15, lq = lane >> 4;
    const bf16_t* P = (const bf16_t*)(WSP() + OFF_P);
    const float* F = (const float*)(WSP() + OFF_F32);
    bf16_t* R2 = (bf16_t*)(WSP() + OFF_R2);
    const int vc = tid & 15, tp = tid >> 4;
    const float gb_i = INP(19)[(dir * 2) * 4 + h], gb_f = INP(19)[(dir * 2 + 1) * 4 + h];
    f32x4 C[8], Cn;
#pragma unroll
    for (int i = 0; i < 8; ++i) C[i] = (f32x4){0.f, 0.f, 0.f, 0.f};
    Cn = (f32x4){0.f, 0.f, 0.f, 0.f};
    float mcar = 0.f;
    __syncthreads();
    for (int i = tid; i < 144 * 136 / 2; i += 512) ((unsigned*)sCt)[i] = 0u;
    __syncthreads();
    bf16x8 Rq[2], Rk[2], Rv[2]; float gli = 0.f, glf = 0.f;
    auto issue = [&](int step) {
        int row0, pos0, seqlen; bool ic; chain_chunk(b, dir, step, row0, pos0, seqlen, ic);
        const int t0 = tp * 2;
        const bf16_t* base = P + (size_t)(row0 + t0) * PLD + h * 128 + vc * 8;
        Rq[0] = *(const bf16x8*)(base + 1536); Rq[1] = *(const bf16x8*)(base + 1536 + PLD);
        Rk[0] = *(const bf16x8*)(base + 2048); Rk[1] = *(const bf16x8*)(base + 2048 + PLD);
        Rv[0] = *(const bf16x8*)(base + 2560); Rv[1] = *(const bf16x8*)(base + 2560 + PLD);
        if (wid == 0) { const int t = dir ? 63 - lane : lane; gli = F[(size_t)(row0 + t) * FLD + (dir * 2) * 4 + h]; glf = F[(size_t)(row0 + t) * FLD + (dir * 2 + 1) * 4 + h]; } };
    issue(0);
    for (int step = 0; step < 36; ++step) {
        int row0, pos0, seqlen; bool is_ctx; chain_chunk(b, dir, step, row0, pos0, seqlen, is_ctx);
        if (wid == 0) {
            const int j = lane, t = dir ? 63 - j : j;
            const float li = gli + gb_i;
            const float lf = logsig_f(glf + gb_f);
            float bsum = lf;
#pragma unroll
            for (int o = 1; o < 64; o <<= 1) { const float n = __shfl_up(bsum, o); if (j >= o) bsum += n; }
            const float u = li - bsum;
            float pmx = u;
#pragma unroll
            for (int o = 1; o < 64; o <<= 1) { const float n = __shfl_up(pmx, o); if (j >= o) pmx = fmaxf(pmx, n); }
            const float pm63 = __shfl(pmx, 63), bend = __shfl(bsum, 63);
            const float Mx = fmaxf(mcar, pm63);
            const float mt = fmaxf(mcar, pmx);
            sRow[t] = -mt; sU[t] = u; sAw[t] = __expf(mcar - mt); sWs[t] = __expf(u - Mx); sEmt[t] = __expf(-(bsum + mt));
            if (j == 0) sScal[0] = __expf(mcar - Mx);
            mcar = bend + Mx;
        }
        {
            const int t0 = tp * 2;
            *(bf16x8*)(sQ + t0 * 136 + vc * 8) = Rq[0]; *(bf16x8*)(sQ + (t0 + 1) * 136 + vc * 8) = Rq[1];
            *(bf16x8*)(sK + t0 * 136 + vc * 8) = Rk[0]; *(bf16x8*)(sK + (t0 + 1) * 136 + vc * 8) = Rk[1];
            *(bf16x8*)(sV + t0 * 136 + vc * 8) = Rv[0]; *(bf16x8*)(sV + (t0 + 1) * 136 + vc * 8) = Rv[1];
            if (step + 1 < 36) issue(step + 1);
        }
        __syncthreads();
        { const int tm = wid >> 1;
#pragma unroll
          for (int q = 0; q < 2; ++q) { const int tn = (wid & 1) * 2 + q; f32x4 acc = (f32x4){0.f, 0.f, 0.f, 0.f};
#pragma unroll
              for (int kk = 0; kk < 128; kk += 32) acc = mfma16(ldsfrag(sQ, 136, tm * 16 + l15, kk + lq * 8), ldsfrag(sK, 136, tn * 16 + l15, kk + lq * 8), acc);
              const int s_ = tn * 16 + l15; const float us = sU[s_];
#pragma unroll
              for (int r = 0; r < 4; ++r) { const int t = tm * 16 + lq * 4 + r; const bool keep = dir ? (s_ >= t) : (s_ <= t);
                  sSc[t * 72 + s_] = f2bf1(keep ? acc[r] * __expf(sRow[t] + us) : 0.f); } } }
        __syncthreads();
        f32x4 num[4];
        { const bf16x8 bv0 = tr_frag<136>(sV, 0, wid * 16, l15, lq), bv1 = tr_frag<136>(sV, 32, wid * 16, l15, lq);
#pragma unroll
          for (int tm = 0; tm < 4; ++tm) { f32x4 acc = (f32x4){0.f, 0.f, 0.f, 0.f};
#pragma unroll
              for (int kk = 0; kk < 128; kk += 32) acc = mfma16(ldsfrag(sQ, 136, tm * 16 + l15, kk + lq * 8), ldsfrag(sCt, 136, wid * 16 + l15, kk + lq * 8), acc);
#pragma unroll
              for (int r = 0; r < 4; ++r) acc[r] *= sAw[tm * 16 + lq * 4 + r];
              acc = mfma16(ldsfrag(sSc, 72, tm * 16 + l15, lq * 8), bv0, acc);
              acc = mfma16(ldsfrag(sSc, 72, tm * 16 + l15, 32 + lq * 8), bv1, acc);
              num[tm] = acc; } }
        if (wid < 4) { const int tm = wid; f32x4 acc = (f32x4){0.f, 0.f, 0.f, 0.f};
            const short one = (l15 == 0) ? (short)0x3F80 : (short)0; const bf16x8 ones = {one, one, one, one, one, one, one, one};
#pragma unroll
            for (int kk = 0; kk < 128; kk += 32) acc = mfma16(ldsfrag(sQ, 136, tm * 16 + l15, kk + lq * 8), ldsfrag(sCt, 136, 128 + l15, kk + lq * 8), acc);
#pragma unroll
            for (int r = 0; r < 4; ++r) acc[r] *= sAw[tm * 16 + lq * 4 + r];
#pragma unroll
            for (int kk = 0; kk < 64; kk += 32) acc = mfma16(ldsfrag(sSc, 72, tm * 16 + l15, kk + lq * 8), ones, acc);
            if (l15 == 0) {
#pragma unroll
                for (int r = 0; r < 4; ++r) sDen[tm * 16 + lq * 4 + r] = acc[r]; } }
        __syncthreads();
#pragma unroll
        for (int tm = 0; tm < 4; ++tm) {
#pragma unroll
            for (int r = 0; r < 4; ++r) { const int t = tm * 16 + lq * 4 + r; const float dn = fmaxf(fabsf(sDen[t]), sEmt[t]);
                sH[t * 136 + wid * 16 + l15] = f2bf1(num[tm][r] * __builtin_amdgcn_rcpf(dn)); } }
        { const float decay = sScal[0];
          bf16x8 bw[2], bn[2];
#pragma unroll
          for (int q = 0; q < 2; ++q) { float xv[8], wv[8]; unpack8(tr_frag<136>(sV, 32 * q, wid * 16, l15, lq), xv);
#pragma unroll
              for (int e = 0; e < 8; ++e) { const float w_ = sWs[32 * q + lq * 8 + e]; xv[e] *= w_; wv[e] = (l15 == 0) ? w_ : 0.f; }
              bw[q] = packf8(xv); bn[q] = packf8(wv); }
#pragma unroll
          for (int kb = 0; kb < 8; ++kb) { C[kb] *= decay;
#pragma unroll
              for (int q = 0; q < 2; ++q) C[kb] = mfma16(tr_frag<136>(sK, 32 * q, kb * 16, l15, lq), bw[q], C[kb]);
              *(uint2*)(sCt + (wid * 16 + l15) * 136 + kb * 16 + lq * 4) = pack4(C[kb]); }
          Cn *= decay;
#pragma unroll
          for (int q = 0; q < 2; ++q) Cn = mfma16(tr_frag<136>(sK, 32 * q, wid * 16, l15, lq), bn[q], Cn);
          *(uint2*)(sCt + (128 + l15) * 136 + wid * 16 + lq * 4) = pack4(Cn); }
        __syncthreads();
#pragma unroll
        for (int i = 0; i < 2; ++i) { const int v = tid + 512 * i, row = v >> 4, cv = v & 15;
            *(bf16x8*)(R2 + (size_t)(row0 + row) * 1024 + dir * 512 + h * 128 + cv * 8) = *(const bf16x8*)(sH + row * 136 + cv * 8); }
    }
}

DEVI void phase_ssd_conv(const Params& p, unsigned char* shm) {
    f32x4* sCwAll = (f32x4*)shm;
    const int tid = tid_l();
    const bf16_t* XBC = (const bf16_t*)(WSP() + OFF_XBC);
    bf16_t* XC = (bf16_t*)(WSP() + OFF_XBCC);
    { const float* cw = INP(24); const float* cb = INP(25);
      for (int i = tid; i < 3072; i += 512) sCwAll[i] = (f32x4){cw[i], cw[3072 + i], cw[6144 + i], cb[i]}; }
    __syncthreads();
    const int ntask = (SLABM / 2) * 384;
    for (int i = bid_l() * 512 + tid; i < ntask; i += gridDim.x * 512) {
        const int v = i % 384, pr = i / 384, r0 = pr * 2;
        int pos, seqlen;
        if (r0 < SLABL) { pos = r0 & (TL - 1); seqlen = TL; } else { pos = (r0 - SLABL) & (TC - 1); seqlen = TC; }
        const bool v0 = pos >= 1, v3 = pos + 2 < seqlen;
        const bf16_t* base = XBC + (size_t)r0 * 3072 + v * 8;
        const long om = v0 ? -3072l : 0l, o3 = v3 ? 6144l : 3072l;
        const bf16x8 a0 = *(const bf16x8*)(base + om), a1 = *(const bf16x8*)(base), a2 = *(const bf16x8*)(base + 3072), a3 = *(const bf16x8*)(base + o3);
        bf16x8 oa, ob; conv2x8(a0, a1, a2, a3, v0, v3, sCwAll + v * 8, oa, ob);
        *(bf16x8*)(XC + (size_t)r0 * 3072 + v * 8) = oa; *(bf16x8*)(XC + (size_t)(r0 + 1) * 3072 + v * 8) = ob;
    }
}

DEVI void ssd_chain(const Params& p, int slab, int lb, int g, int hp, int dir, unsigned char* shm) {
    bf16_t* sC = (bf16_t*)shm;
    bf16_t* sB = sC + 64 * 136;
    bf16_t* sX = sB + 64 * 136;
    bf16_t* sW = sX + 64 * 136;
    bf16_t* sS = sW + 2 * 64 * 72;
    float* sCum = (float*)(sS + 2 * 64 * 136);
    float* sDt = sCum + 128;
    float* sWend = sDt + 128;
    float* sEcum = sWend + 128;
    float* sDec = sEcum + 128;
    f32x4* sCw = (f32x4*)(sDec + 4);
    const int tid = tid_l(), wid = tid >> 6, lane = tid & 63, l15 = lane & 15, lq = lane >> 4;
    const bf16_t* XBC = (const bf16_t*)(WSP() + OFF_XBCC);
    const float* DT = (const float*)(WSP() + OFF_DT);
    bf16_t* Y = (bf16_t*)(WSP() + (dir ? OFF_YB : OFF_YF));
    const int h0 = g * 8 + hp * 2;
    const int vc = tid & 15, tp = tid >> 4;
    const int hh = wid >> 2, pq = wid & 3;
    const int hmine = h0 + hh;
    const float Dh = INP(28)[hmine];
    const int hdt = h0 + (wid & 1);
    const float dtb = INP(26)[dir * 32 + hdt], Ah = -__expf(INP(27)[dir * 32 + hdt]);
    f32x4 St[8];
#pragma unroll
    for (int i = 0; i < 8; ++i) St[i] = (f32x4){0.f, 0.f, 0.f, 0.f};
    __syncthreads();
    for (int i = tid; i < 2 * 64 * 136 / 2; i += 512) ((unsigned*)sS)[i] = 0u;
    __syncthreads();
    bf16x8 R[3][2]; float dtr = 0.f;
    auto chunk_of = [&](int step, int& pos0, int& seqlen, int& lrow0, bool& is_ctx) {
        if (step < 4) { const int cc = dir ? 3 - step : step; is_ctx = true; pos0 = cc * 64; seqlen = TC; lrow0 = SLABL + lb * TC + pos0; }
        else { const int cc = dir ? 31 - (step - 4) : (step - 4); is_ctx = false; pos0 = cc * 64; seqlen = TL; lrow0 = lb * TL + pos0; } };
    auto issue = [&](int step) {
        int pos0, seqlen, lrow0; bool ic; chunk_of(step, pos0, seqlen, lrow0, ic);
        const int t0 = tp * 2;
        const bf16_t* base = XBC + (size_t)(lrow0 + t0) * 3072 + vc * 8;
#pragma unroll
        for (int m = 0; m < 3; ++m) { const int cb = (m == 0 ? 2048 + g * 128 : (m == 1 ? 2560 + g * 128 : h0 * 64));
            R[m][0] = *(const bf16x8*)(base + cb); R[m][1] = *(const bf16x8*)(base + cb + 3072); }
        if (wid < 2) { const int t = dir ? 63 - lane : lane; dtr = DT[(size_t)(lrow0 + t) * 64 + dir * 32 + hdt]; } };
    issue(0);
    for (int step = 0; step < 36; ++step) {
        int pos0, seqlen, lrow0; bool is_ctx; chunk_of(step, pos0, seqlen, lrow0, is_ctx);
        if (wid < 2) {
            const int j = lane, t = dir ? 63 - j : j;
            const float dt = softplus_f(dtr + dtb);
            float cum = dt * Ah;
#pragma unroll
            for (int o = 1; o < 64; o <<= 1) { const float n = __shfl_up(cum, o); if (j >= o) cum += n; }
            const float cend = __shfl(cum, 63);
            sCum[wid * 64 + t] = cum; sDt[wid * 64 + t] = dt; sWend[wid * 64 + t] = __expf(cend - cum) * dt; sEcum[wid * 64 + t] = __expf(cum);
            if (j == 0) sDec[wid] = __expf(cend);
        }
        {
            const int t0 = tp * 2;
#pragma unroll
            for (int m = 0; m < 3; ++m) {
                if (m == 1 && is_ctx) continue;
                bf16_t* dst = (m == 0 ? sB : (m == 1 ? sC : sX));
                *(bf16x8*)(dst + t0 * 136 + vc * 8) = R[m][0]; *(bf16x8*)(dst + (t0 + 1) * 136 + vc * 8) = R[m][1]; }
            if (step + 1 < 36) issue(step + 1);
        }
        __syncthreads();
        if (!is_ctx) { const int tm = wid >> 1;
#pragma unroll
          for (int q = 0; q < 2; ++q) { const int tn = (wid & 1) * 2 + q; f32x4 acc = (f32x4){0.f, 0.f, 0.f, 0.f};
#pragma unroll
              for (int kk = 0; kk < 128; kk += 32) acc = mfma16(ldsfrag(sC, 136, tm * 16 + l15, kk + lq * 8), ldsfrag(sB, 136, tn * 16 + l15, kk + lq * 8), acc);
              const int s_ = tn * 16 + l15;
#pragma unroll
              for (int h2 = 0; h2 < 2; ++h2) { const float cs = sCum[h2 * 64 + s_], ds = sDt[h2 * 64 + s_]; const f32x4 ct = *(const f32x4*)(sCum + h2 * 64 + tm * 16 + lq * 4);
#pragma unroll
                  for (int r = 0; r < 4; ++r) { const int t = tm * 16 + lq * 4 + r; const bool keep = dir ? (s_ >= t) : (s_ <= t);
                      sW[(h2 * 64 + t) * 72 + s_] = f2bf1(keep ? acc[r] * __expf(ct[r] - cs) * ds : 0.f); } } } }
        __syncthreads();
        const bf16_t* sSh = sS + hh * 64 * 136;
        const bf16x8 bx0 = tr_frag<136>(sX, 0, hh * 64 + pq * 16, l15, lq), bx1 = tr_frag<136>(sX, 32, hh * 64 + pq * 16, l15, lq);
        if (!is_ctx) {
#pragma unroll
            for (int tm = 0; tm < 4; ++tm) { f32x4 acc = (f32x4){0.f, 0.f, 0.f, 0.f};
#pragma unroll
                for (int kk = 0; kk < 128; kk += 32) acc = mfma16(ldsfrag(sC, 136, tm * 16 + l15, kk + lq * 8), ldsfrag(sSh, 136, pq * 16 + l15, kk + lq * 8), acc);
                { const f32x4 ec = *(const f32x4*)(sEcum + hh * 64 + tm * 16 + lq * 4);
#pragma unroll
                  for (int r = 0; r < 4; ++r) acc[r] *= ec[r]; }
                acc = mfma16(ldsfrag(sW, 72, hh * 64 + tm * 16 + l15, lq * 8), bx0, acc);
                acc = mfma16(ldsfrag(sW, 72, hh * 64 + tm * 16 + l15, 32 + lq * 8), bx1, acc);
                if (!dir) {
#pragma unroll
                    for (int r = 0; r < 4; ++r) acc[r] += Dh * bf2f(sX[(tm * 16 + lq * 4 + r) * 136 + hh * 64 + pq * 16 + l15]); }
#pragma unroll
                for (int r = 0; r < 4; ++r) Y[(size_t)(lrow0 + tm * 16 + lq * 4 + r) * 2048 + hmine * 64 + pq * 16 + l15] = f2bf1(acc[r]); }
        }
        { bf16x8 bx[2];
#pragma unroll
          for (int q = 0; q < 2; ++q) { float xv[8]; unpack8(q ? bx1 : bx0, xv);
#pragma unroll
              for (int e = 0; e < 8; ++e) xv[e] *= sWend[hh * 64 + q * 32 + lq * 8 + e];
              bx[q] = packf8(xv); }
          const float dec = sDec[hh];
#pragma unroll
          for (int nb = 0; nb < 8; ++nb) { St[nb] *= dec;
#pragma unroll
              for (int q = 0; q < 2; ++q) St[nb] = mfma16(tr_frag<136>(sB, q * 32, nb * 16, l15, lq), bx[q], St[nb]);
              *(uint2*)(sS + hh * 64 * 136 + (pq * 16 + l15) * 136 + nb * 16 + lq * 4) = pack4(St[nb]); } }
        __syncthreads();
    }
}

DEVI float sum16(float v) { v += __shfl_xor(v, 1); v += __shfl_xor(v, 2); v += __shfl_xor(v, 4); v += __shfl_xor(v, 8); return v; }
DEVI void phase_even_combine(const Params& p) {
    const int tid_ = tid_l(); const int wid = tid_ >> 6, lane = tid_ & 63;
    const bf16_t* P = (const bf16_t*)(WSP() + OFF_P);
    bf16_t* R1 = (bf16_t*)(WSP() + OFF_H);
    const bf16_t* R2 = (const bf16_t*)(WSP() + OFF_R2);
    float gn[8], mn[8];
#pragma unroll
    for (int e = 0; e < 8; ++e) { gn[e] = INP(20)[lane * 8 + e]; mn[e] = INP(21)[lane * 8 + e]; }
    const int stride = gridDim.x * 8;
    int row = bid_l() * 8 + wid;
    bf16x8 c[6], n[6];
    auto ldrow = [&](int r, bf16x8 (&d)[6]) {
        d[0] = *(const bf16x8*)(R1 + (size_t)r * 1024 + lane * 8); d[1] = *(const bf16x8*)(R1 + (size_t)r * 1024 + 512 + lane * 8);
        d[2] = *(const bf16x8*)(P + (size_t)r * PLD + 1024 + lane * 8); d[3] = *(const bf16x8*)(R2 + (size_t)r * 1024 + lane * 8);
        d[4] = *(const bf16x8*)(R2 + (size_t)r * 1024 + 512 + lane * 8); d[5] = *(const bf16x8*)(P + (size_t)r * PLD + 3072 + lane * 8); };
    if (row < MTOT) ldrow(row, c);
    for (; row < MTOT; row += stride) {
        if (row + stride < MTOT) ldrow(row + stride, n);
        float of[8], ob[8], gg[8], hf[8], hb[8], mo[8];
        unpack8(c[0], of); unpack8(c[1], ob); unpack8(c[2], gg); unpack8(c[3], hf); unpack8(c[4], hb); unpack8(c[5], mo);
        float s1 = 0.f, s2 = 0.f;
#pragma unroll
        for (int e = 0; e < 8; ++e) { of[e] += ob[e]; s1 += of[e] * of[e]; hf[e] = sigmoid_f(mo[e]) * (hf[e] + hb[e]); s2 += hf[e] * hf[e]; }
        s1 = sum16(s1); s2 = sum16(s2);
        const float r1 = rsqrtf(s1 * (1.f / 128.f) + 1e-6f), r2 = rsqrtf(s2 * (1.f / 128.f) + 1e-6f);
#pragma unroll
        for (int e = 0; e < 8; ++e) { of[e] = of[e] * r1 * gn[e] * silu_f(gg[e]); hf[e] = hf[e] * r2 * mn[e]; }
        *(bf16x8*)(R1 + (size_t)row * 1024 + lane * 8) = packf8(of);
        *(bf16x8*)(R1 + (size_t)row * 1024 + 512 + lane * 8) = packf8(hf);
#pragma unroll
        for (int i = 0; i < 6; ++i) c[i] = n[i];
    }
}
DEVI void phase_odd_combine(const Params& p) {
    const int tid_ = tid_l(); const int wid = tid_ >> 6, lane = tid_ & 63;
    bf16_t* Z = (bf16_t*)(WSP() + OFF_Z);
    const bf16_t* YF = (const bf16_t*)(WSP() + OFF_YF);
    const bf16_t* YB = (const bf16_t*)(WSP() + OFF_YB);
    const float* ng = INP(29);
    f32x4 ngv[4][2];
#pragma unroll
    for (int gi = 0; gi < 4; ++gi) { ngv[gi][0] = *(const f32x4*)(ng + gi * 512 + lane * 8); ngv[gi][1] = *(const f32x4*)(ng + gi * 512 + lane * 8 + 4); }
    const int stride = gridDim.x * 8;
    int row = bid_l() * 8 + wid;
    bf16x8 c[12], n[12];
    auto ldrow = [&](int r, bf16x8 (&d)[12]) {
#pragma unroll
        for (int gi = 0; gi < 4; ++gi) { const int ch = gi * 512 + lane * 8;
            d[gi * 3] = *(const bf16x8*)(YF + (size_t)r * 2048 + ch); d[gi * 3 + 1] = *(const bf16x8*)(YB + (size_t)r * 2048 + ch); d[gi * 3 + 2] = *(const bf16x8*)(Z + (size_t)r * 2048 + ch); } };
    if (row < SLABL) ldrow(row, c);
    for (; row < SLABL; row += stride) {
        if (row + stride < SLABL) ldrow(row + stride, n);
#pragma unroll
        for (int gi = 0; gi < 4; ++gi) { const int ch = gi * 512 + lane * 8; float yf[8], yb[8], z[8];
            unpack8(c[gi * 3], yf); unpack8(c[gi * 3 + 1], yb); unpack8(c[gi * 3 + 2], z);
            float ss = 0.f;
#pragma unroll
            for (int e = 0; e < 8; ++e) { yf[e] = (yf[e] + yb[e]) * silu_f(z[e]); ss += yf[e] * yf[e]; }
            ss = wave_sum(ss);
            const float rs = rsqrtf(ss * (1.f / 512.f) + 1e-6f);
#pragma unroll
            for (int e = 0; e < 8; ++e) yf[e] = yf[e] * rs * ngv[gi][e >> 2][e & 3];
            *(bf16x8*)(Z + (size_t)row * 2048 + ch) = packf8(yf); }
#pragma unroll
        for (int i = 0; i < 12; ++i) c[i] = n[i];
    }
}

DEVI void phase_convact(const Params& p, int layer, int grp, bool with_ctx) {
    const int tid = tid_l(), wid = tid >> 6, lane = tid & 63;
    const int w = grp == 2 ? 768 : 1024, j0 = grp * 1024, ldu = 2 * w, nvb = w / 256;
    const int segw = grp == 2 ? 8 : 32, nseg = 64 / segw;
    const bf16_t* U = (const bf16_t*)(WSP() + OFF_U);
    bf16_t* ACT = (bf16_t*)(WSP() + OFF_ACT);
    const float* cw = INP(10) + (size_t)layer * 9 * NUP;
    const float* cbias = INP(11) + (size_t)layer * NUP;
    const int nlat = 16 * 2 * nvb * nseg, nctx = with_ctx ? 16 * nvb * 4 : 0;
    for (int u = bid_l(); u < nlat + nctx; u += gridDim.x) {
        int img_row0, H, Wd, r0, c0, nc, vb;
        if (u < nlat) { int q = u; const int seg = q % nseg; q /= nseg; vb = q % nvb; q /= nvb; const int band = q & 1; const int img = q >> 1;
            img_row0 = img * TL; H = 32; Wd = 64; r0 = band * 16 + wid * 2; c0 = seg * segw; nc = segw; }
        else { int q = u - nlat; const int quarter = q & 3; q >>= 2; vb = q % nvb; const int img = q / nvb; img_row0 = MLAT + img * TC; H = 1; Wd = 256; r0 = 0; c0 = quarter * 64 + wid * 8; nc = 8; }
        const bool two = (r0 + 1 < H);
        const int j = vb * 256 + lane * 4;
        const int cha = j0 + j, chg = 2816 + j0 + j;
        float wa[9][4], wg[9][4], ba[4], bg[4];
#pragma unroll
        for (int q = 0; q < 9; ++q) { const f32x4 a = *(const f32x4*)(cw + q * NUP + cha), g = *(const f32x4*)(cw + q * NUP + chg);
#pragma unroll
            for (int e = 0; e < 4; ++e) { wa[q][e] = a[e]; wg[q][e] = g[e]; } }
        { const f32x4 a = *(const f32x4*)(cbias + cha), g = *(const f32x4*)(cbias + chg);
#pragma unroll
          for (int e = 0; e < 4; ++e) { ba[e] = a[e]; bg[e] = g[e]; } }
        f32x4 Wa[4][3], Wg[4][3]; uint2 Na[4], Ng[4];
        auto ld = [&](int rr, int cc, uint2& va, uint2& vg) {
            const bool ok = rr >= 0 && rr < H && cc >= 0 && cc < Wd;
            const int rc = min(max(rr, 0), H - 1), ccl = min(max(cc, 0), Wd - 1);
            const bf16_t* q = U + (size_t)(img_row0 + rc * Wd + ccl) * ldu + j; va = *(const uint2*)q; vg = *(const uint2*)(q + w);
            if (!ok) { va = make_uint2(0u, 0u); vg = make_uint2(0u, 0u); } };
        auto up = [&](uint2 a) { f32x4 r; r[0] = __uint_as_float(a.x << 16); r[1] = __uint_as_float(a.x & 0xFFFF0000u); r[2] = __uint_as_float(a.y << 16); r[3] = __uint_as_float(a.y & 0xFFFF0000u); return r; };
#pragma unroll
        for (int dy = 0; dy < 4; ++dy) { uint2 a, g; ld(r0 + dy - 1, c0 - 1, a, g); Wa[dy][1] = up(a); Wg[dy][1] = up(g); ld(r0 + dy - 1, c0, a, g); Wa[dy][2] = up(a); Wg[dy][2] = up(g); ld(r0 + dy - 1, c0 + 1, Na[dy], Ng[dy]); }
#pragma unroll 6
        for (int cc = c0; cc < c0 + nc; ++cc) {
#pragma unroll
            for (int dy = 0; dy < 4; ++dy) { Wa[dy][0] = Wa[dy][1]; Wa[dy][1] = Wa[dy][2]; Wa[dy][2] = up(Na[dy]); Wg[dy][0] = Wg[dy][1]; Wg[dy][1] = Wg[dy][2]; Wg[dy][2] = up(Ng[dy]); }
#pragma unroll
            for (int dy = 0; dy < 4; ++dy) ld(r0 + dy - 1, cc + 2, Na[dy], Ng[dy]);
            float sa[2][4], sg[2][4];
#pragma unroll
            for (int o = 0; o < 2; ++o)
#pragma unroll
                for (int e = 0; e < 4; ++e) { sa[o][e] = ba[e]; sg[o][e] = bg[e]; }
#pragma unroll
            for (int dy = 0; dy < 4; ++dy)
#pragma unroll
                for (int dx = 0; dx < 3; ++dx) { const f32x4 a = Wa[dy][dx], g = Wg[dy][dx];
                    if (dy < 3) { const int q = dy * 3 + dx;
#pragma unroll
                        for (int e = 0; e < 4; ++e) { sa[0][e] += wa[q][e] * a[e]; sg[0][e] += wg[q][e] * g[e]; } }
                    if (dy >= 1) { const int q = (dy - 1) * 3 + dx;
#pragma unroll
                        for (int e = 0; e < 4; ++e) { sa[1][e] += wa[q][e] * a[e]; sg[1][e] += wg[q][e] * g[e]; } } }
            { uint2 o; o.x = pack2(silu_f(sg[0][0]) * sa[0][0], silu_f(sg[0][1]) * sa[0][1]); o.y = pack2(silu_f(sg[0][2]) * sa[0][2], silu_f(sg[0][3]) * sa[0][3]);
              *(uint2*)(ACT + (size_t)(img_row0 + r0 * Wd + cc) * DFF + j0 + j) = o; }
            if (two) { uint2 o; o.x = pack2(silu_f(sg[1][0]) * sa[1][0], silu_f(sg[1][1]) * sa[1][1]); o.y = pack2(silu_f(sg[1][2]) * sa[1][2], silu_f(sg[1][3]) * sa[1][3]);
              *(uint2*)(ACT + (size_t)(img_row0 + (r0 + 1) * Wd + cc) * DFF + j0 + j) = o; }
        }
    }
}

#define XB_TMO      128
#define XB_XCNT(j)  (256  + 64 * (j))
#define XB_XSUB(j)  (1280 + 64 * (j))
#define XB_XGEN(j)  (2304 + 64 * (j))
#define XB_TOP      3328
#define XB_TOPGEN   3392
#define XCD_BAR_WORDS 3456
#define XB_SPIN_CAP (1u << 22)
DEVI unsigned xb_ld(unsigned* p)              { return __hip_atomic_load(p, __ATOMIC_RELAXED, __HIP_MEMORY_SCOPE_AGENT); }
DEVI unsigned xb_add(unsigned* p, unsigned v) { return __hip_atomic_fetch_add(p, v, __ATOMIC_RELAXED, __HIP_MEMORY_SCOPE_AGENT); }
DEVI unsigned xb_xcc_id() { return (unsigned)__builtin_amdgcn_s_getreg((3 << 11) | 20) & 0xFu; }
#define XB_SPIN(cond, bar) do { unsigned _sp = 0; while (cond) { __builtin_amdgcn_s_sleep(1); \
    if ((++_sp & 255u) == 0u) { if (xb_ld(&(bar)[XB_TMO])) break; if (_sp > XB_SPIN_CAP) { atomicAdd(&(bar)[XB_TMO], 1u); break; } } } } while (0)
struct XcdBarrier { unsigned* bar; unsigned x; volatile LAS unsigned* st; };
DEVI XcdBarrier xcd_barrier_post(unsigned* bar, volatile LAS unsigned* st) {
    XcdBarrier b; b.bar = bar; b.x = xb_xcc_id(); b.st = st;
    if (threadIdx.x == 0) (void)xb_add(&bar[XB_XCNT(b.x)], 1u);
    return b;
}
DEVI void xcd_barrier_complete(unsigned* bar, unsigned x, unsigned& nloc, unsigned& nx) {
    const unsigned G = gridDim.x * gridDim.y * gridDim.z;
    unsigned sum, cnt, mine, sp = 0u;
    for (;;) {
        sum = 0u; cnt = 0u; mine = 0u;
#pragma unroll
        for (unsigned j = 0; j < 16; ++j) { const unsigned c = xb_ld(&bar[XB_XCNT(j)]); sum += c; cnt += (c > 0u) ? 1u : 0u; mine = (j == x) ? c : mine; }
        if (sum == G) break;
        __builtin_amdgcn_s_sleep(1);
        if ((++sp & 255u) == 0u) { if (xb_ld(&bar[XB_TMO])) break; if (sp > XB_SPIN_CAP) { atomicAdd(&bar[XB_TMO], 1u); break; } }
    }
    nloc = mine > 0u ? mine : 1u; nx = cnt > 0u ? cnt : 1u;
}
DEVI void xcd_barrier(const XcdBarrier& b) {
    asm volatile("s_waitcnt vmcnt(0)" ::: "memory");
    __syncthreads();
    if (threadIdx.x == 0) {
        unsigned* bar = b.bar;
        __builtin_amdgcn_s_waitcnt(0);
        unsigned nloc = b.st[0], nx = b.st[1];
        if (nloc == 0u) { xcd_barrier_complete(bar, b.x, nloc, nx); b.st[0] = nloc; b.st[1] = nx; }
        const unsigned old = xb_add(&bar[XB_XSUB(b.x)], 1u);
        const unsigned gen = old / nloc;
        if (old + 1u == (gen + 1u) * nloc) {
            __builtin_amdgcn_fence(__ATOMIC_RELEASE, "agent");
            asm volatile("s_waitcnt vmcnt(0)" ::: "memory");
            const unsigned og = xb_add(&bar[XB_TOP], 1u);
            const unsigned tg = og / nx;
            if (og + 1u == (tg + 1u) * nx) xb_add(&bar[XB_TOPGEN], 1u);
            else XB_SPIN(xb_ld(&bar[XB_TOPGEN]) == tg, bar);
            __builtin_amdgcn_fence(__ATOMIC_ACQUIRE, "agent");
            xb_add(&bar[XB_XGEN(b.x)], 1u);
            asm volatile("s_waitcnt vmcnt(0)" ::: "memory");
        } else {
            XB_SPIN(xb_ld(&bar[XB_XGEN(b.x)]) == gen, bar);
            __builtin_amdgcn_fence(__ATOMIC_ACQUIRE, "agent");
            asm volatile("s_waitcnt vmcnt(0)" ::: "memory");
        }
    }
    __syncthreads();
}
constexpr size_t OFF_BAR = OFF_MOD + 900 * 1024;
constexpr int LDS_CTL = 131072 + 64;

#ifndef ONLYG
#define ONLYG -1
#endif
#define GEN(x) (ONLYG < 0 || ONLYG == (x))
#ifndef REP
#define REP 0
#endif
#define REPEAT(bit, ...) do { __VA_ARGS__; if (REP & (bit)) { xcd_barrier(xbar); __VA_ARGS__; } } while (0)
__global__ void __launch_bounds__(512) mega(Params p) {
    extern __shared__ __attribute__((aligned(16))) unsigned char shm[];
    volatile LAS unsigned* xst = (volatile LAS unsigned*)((LAS unsigned char*)shm + LDS_CTL);
    if (threadIdx.x == 0) { xst[0] = 0u; xst[1] = 0u; }
    __syncthreads();
    XcdBarrier xbar = xcd_barrier_post((unsigned*)(WSP() + OFF_BAR), xst);
    int ph = 0;
#define PH_BEGIN if (ph >= PH_LO() && ph < PH_HI()) { unsigned char* ws = WSP(); bf16_t* Wb = (bf16_t*)(ws + OFF_W); bf16_t* Hb = (bf16_t*)(ws + OFF_H); float* Xc = (float*)(ws + OFF_XC); const float* MOD = (const float*)(ws + OFF_MOD); (void)Wb; (void)Hb; (void)Xc; (void)MOD;
#define PH_END if (ph + 1 < PH_HI()) { xcd_barrier(xbar); } } ++ph;
    PH_BEGIN if (GEN(0)) REPEAT(16, phase_prep(p, shm)); PH_END
    PH_BEGIN if (GEN(1)) REPEAT(64, phase_modulate(p, INP(0), INP(2), MTOT, INP(6), 0, 0, OUTP(), Xc)); PH_END
    PH_BEGIN if (GEN(2)) { EpiInL0 e{(bf16_t*)(ws + OFF_P), (float*)(ws + OFF_F32), (bf16_t*)(ws + OFF_R2)}; run_gemm(shm, Hb, Wb + W0IN, MTOT, N0IN, 1024, e); } PH_END
    PH_BEGIN if (GEN(3) || ONLYG == 33) phase_ml_conv(p, shm); PH_END
    PH_BEGIN
        REPEAT(1, for (int u = bid_l(); u < 256; u += gridDim.x) {
            const int s_ = (u & 7) + 8 * ((u >> 3) & 15), dir = u >> 7, kind = s_ & 1, h = (s_ >> 1) & 3, b = s_ >> 3;
            if (kind == 0) { if (GEN(3) || ONLYG == 33) mlstm_chain(p, b, h, dir, shm); } else { if (GEN(3) || ONLYG == 34) gla_chain(p, b, h, dir, shm); }
        });
    PH_END
    PH_BEGIN if (GEN(4)) phase_even_combine(p); PH_END
    PH_BEGIN if (GEN(5)) { EpiResid e{OUTP(), Xc, MOD, 2048, 0}; run_gemm(shm, Hb, Wb + W0OUT, MTOT, 1024, 1024, e); } PH_END
    PH_BEGIN if (GEN(1)) REPEAT(64, phase_modulate(p, OUTP(), Xc, MTOT, INP(7), 0, 3072)); PH_END
    for (int g = 0; g < 3; ++g) {
        PH_BEGIN if (GEN(7)) { EpiBf16 e{(bf16_t*)(ws + OFF_U), g == 2 ? 1536 : 2048}; REPEAT(8, run_gemm(shm, Hb, Wb + UP0 + (size_t)g * 2048 * 1024, MTOT, g == 2 ? 1536 : 2048, 1024, e)); } PH_END
        PH_BEGIN if (GEN(8)) REPEAT(4, phase_convact(p, 0, g, true)); PH_END
    }
    PH_BEGIN if (GEN(5)) { EpiResid e{OUTP(), Xc, MOD, 5120, 0}; run_gemm(shm, (const bf16_t*)(ws + OFF_ACT), Wb + DN0, MLAT, 1024, DFF, e); } PH_END
    PH_BEGIN
        if ((int)bid_l() < 64) { if (GEN(5)) { EpiResid e{OUTP(), Xc, MOD, 5120, MLAT}; run_gemm(shm, (const bf16_t*)(ws + OFF_ACT) + (size_t)MLAT * DFF, Wb + DN0, MCTX, 1024, DFF, e, 1 << 30, 0, 0, 64); } }
        else { if (GEN(1)) phase_modulate(p, OUTP(), Xc, MLAT, INP(6) + 1024, 1, 0, nullptr, nullptr, 0, 64); }
    PH_END
    PH_BEGIN if (GEN(1)) phase_modulate(p, OUTP(), Xc, MTOT, INP(6) + 1024, 1, 0, nullptr, nullptr, MLAT, 0); PH_END
    for (int slab = 0; slab < 2; ++slab) {
        PH_BEGIN if (GEN(15)) { EpiInL1 e{(bf16_t*)(ws + OFF_XBC), (bf16_t*)(ws + OFF_Z), (float*)(ws + OFF_DT)};
            run_gemm(shm, Hb, Wb + W1IN, SLABM, N1IN, 1024, e, 64, 64 * slab, 128 + 8 * slab); } PH_END
        PH_BEGIN if (GEN(16)) phase_ssd_conv(p, shm); PH_END
        PH_BEGIN if (GEN(16)) REPEAT(2, for (int u = bid_l(); u < 256; u += gridDim.x) { const int s_ = (u & 7) + 8 * ((u >> 3) & 3), j_ = u >> 5, dir = j_ & 1, hp = j_ >> 1, g = s_ & 3, lb = s_ >> 2; ssd_chain(p, slab, lb, g, hp, dir, shm); }); PH_END
        PH_BEGIN if (GEN(17)) phase_odd_combine(p); PH_END
        PH_BEGIN if (GEN(5)) { EpiResid e{OUTP(), Xc, MOD + 17 * 6144, 2048, SLABL * slab}; run_gemm(shm, (const bf16_t*)(ws + OFF_Z), Wb + W1OUT, SLABL, 1024, 2048, e); } PH_END
    }
    PH_BEGIN if (GEN(1)) REPEAT(64, phase_modulate(p, OUTP(), Xc, MLAT, INP(7) + 1024, 1, 3072)); PH_END
    for (int g = 0; g < 3; ++g) {
        PH_BEGIN if (GEN(7)) { EpiBf16 e{(bf16_t*)(ws + OFF_U), g == 2 ? 1536 : 2048}; REPEAT(8, run_gemm(shm, Hb, Wb + UP1 + (size_t)g * 2048 * 1024, MLAT, g == 2 ? 1536 : 2048, 1024, e)); } PH_END
        PH_BEGIN if (GEN(8)) REPEAT(4, phase_convact(p, 1, g, false)); PH_END
    }
    PH_BEGIN if (GEN(5)) { EpiResid e{OUTP(), Xc, MOD + 17 * 6144, 5120, 0}; run_gemm(shm, (const bf16_t*)(ws + OFF_ACT), Wb + DN1, MLAT, 1024, DFF, e); } PH_END
    PH_BEGIN if (REP & 32) { for (int i = 0; i < 20; ++i) cg::this_grid().sync(); } if (GEN(1)) phase_final_norm(p); PH_END
    if (PH_HI() > 4096) cg::this_grid().sync();
}

#ifndef N_LAUNCH_PER_PHASE
#define N_LAUNCH_PER_PHASE 0
#endif

extern "C" void kernel_launch(void* const* d_in, const int* in_sizes, int n_in, void* d_out, int out_size, void* d_ws, size_t ws_size, hipStream_t stream) {
    static int grid = 0;
    if (grid == 0) {
        if (n_in != 31 || ws_size < WS_NEED) { fprintf(stderr, "kernel_launch: unexpected n_in %d or ws_size %zu (< %zu)\n", n_in, ws_size, (size_t)WS_NEED); grid = -1; return; }
        int dev = 0, cus = 0, per_cu = 0;
        hipGetDevice(&dev);
        hipDeviceGetAttribute(&cus, hipDeviceAttributeMultiprocessorCount, dev);
        if (hipFuncSetAttribute((const void*)mega, hipFuncAttributeMaxDynamicSharedMemorySize, LDS_BYTES) != hipSuccess) { fprintf(stderr, "kernel_launch: hipFuncSetAttribute failed\n"); grid = -1; return; }
        hipOccupancyMaxActiveBlocksPerMultiprocessor(&per_cu, (const void*)mega, 512, LDS_BYTES);
        if (per_cu < 1) { fprintf(stderr, "kernel_launch: occupancy query says %d blocks per CU\n", per_cu); per_cu = 1; }
        (void)hipGetLastError();
        grid = cus * 1;
    }
    if (grid < 0) return;
    Params p{};
    for (int i = 0; i < 31; ++i) p.in[i] = (const float*)d_in[i];
    p.out = (float*)d_out; p.ws = (unsigned char*)d_ws;
#if N_LAUNCH_PER_PHASE
    for (int ph = 0; ph < NPHASE; ++ph) {
        p.ph_lo = ph; p.ph_hi = ph + 1;
        hipLaunchKernelGGL(mega, dim3(grid), dim3(512), LDS_BYTES, stream, p);
    }
#else
    p.ph_lo = 0; p.ph_hi = NPHASE;
    if (hipMemsetAsync((unsigned char*)d_ws + OFF_BAR, 0, XCD_BAR_WORDS * 4, stream) != hipSuccess) { fprintf(stderr, "kernel_launch: memset of barrier words failed\n"); return; }
    void* args[] = {&p};
    hipError_t e = hipLaunchCooperativeKernel((const void*)mega, dim3(grid), dim3(512), args, LDS_BYTES, stream);
    if (e != hipSuccess) fprintf(stderr, "cooperative launch failed: %s (grid %d)\n", hipGetErrorString(e), grid);
#endif
}
```

```cpp
#include <hip/hip_runtime.h>
#include <hip/hip_cooperative_groups.h>
#include <cstdio>
#include <cstdint>
namespace cg = cooperative_groups;

#define DEVI __device__ __forceinline__
#define LAS __attribute__((address_space(3)))
typedef unsigned short bf16_t;
typedef short bf16x8 __attribute__((ext_vector_type(8)));
typedef float f32x4 __attribute__((ext_vector_type(4)));

constexpr int NB = 16, TL = 2048, TC = 256, DM = 1024;
constexpr int MLAT = NB * TL;
constexpr int MCTX = NB * TC;
constexpr int MTOT = MLAT + MCTX;
constexpr int PLD = 3584;
constexpr int FLD = 48;
constexpr int N0IN = 3840, N1IN = 5376, DFF = 2816, NUP = 5632;
constexpr int SLABM = 18432, SLABL = 16384, SLABC = 2048;

constexpr size_t MiB = 1ull << 20;
constexpr size_t OFF_XC = 0;
constexpr size_t OFF_MOD = 16 * MiB;
constexpr size_t OFF_W = 17 * MiB;
constexpr size_t W0IN = 0, W0OUT = W0IN + (size_t)N0IN * 1024, UP0 = W0OUT + 1024 * 1024, DN0 = UP0 + (size_t)NUP * 1024,
                 W1IN = DN0 + (size_t)1024 * DFF, W1OUT = W1IN + (size_t)N1IN * 1024, UP1 = W1OUT + (size_t)1024 * 2048,
                 DN1 = UP1 + (size_t)NUP * 1024, WEND = DN1 + (size_t)1024 * DFF;
constexpr size_t OFF_H = 75 * MiB;
constexpr size_t OFF_BIG = 147 * MiB;
constexpr size_t OFF_P = OFF_BIG, OFF_F32 = OFF_BIG + 252 * MiB, OFF_R2 = OFF_BIG + 259 * MiB;
constexpr size_t OFF_U = OFF_BIG, OFF_ACT = OFF_BIG + 144 * MiB;
constexpr size_t OFF_XBC = OFF_BIG, OFF_Z = OFF_BIG + 108 * MiB, OFF_DT = OFF_BIG + 172 * MiB, OFF_XBCC = OFF_BIG + 177 * MiB, OFF_YF = OFF_BIG, OFF_YB = OFF_BIG + 285 * MiB;
constexpr size_t WS_NEED = OFF_BIG + 349 * MiB;
static_assert(WEND * 2 <= 58 * MiB, "weights region");

constexpr int LDS_BYTES = 144 * 1024;
constexpr int NPHASE = 37;

struct Params {
    const float* in[31];
    float* out;
    unsigned char* ws;
    int ph_lo, ph_hi;
};


#define GAS __attribute__((address_space(1)))
template <int OFF> DEVI const void* karg_ptr() { const GAS char* r; asm volatile("s_load_dwordx2 %0, %1, %2\n\ts_waitcnt lgkmcnt(0)" : "=s"(r) : "s"(__builtin_amdgcn_kernarg_segment_ptr()), "n"(OFF));
    return (const void*)r; }
#define INP(i) ((const float*)karg_ptr<(i) * 8>())
#define OUTP() ((float*)karg_ptr<31 * 8>())
#define WSP() ((unsigned char*)karg_ptr<32 * 8>())
template <int OFF> DEVI int karg_int() { int r; asm volatile("s_load_dword %0, %1, %2\n\ts_waitcnt lgkmcnt(0)" : "=s"(r) : "s"(__builtin_amdgcn_kernarg_segment_ptr()), "n"(OFF)); return r; }
#define PH_LO() karg_int<33 * 8>()
#define PH_HI() karg_int<33 * 8 + 4>()
DEVI int tid_l() { int t = threadIdx.x; asm volatile("" : "+v"(t)); return t; }
DEVI int bid_l() { int t = blockIdx.x; asm volatile("" : "+s"(t)); return t; }
DEVI bf16_t f2bf(float f) { unsigned u = __float_as_uint(f); u += 0x7FFFu + ((u >> 16) & 1u); return (bf16_t)(u >> 16); }
DEVI float bf2f(bf16_t b) { return __uint_as_float(((unsigned)b) << 16); }
typedef __bf16 bf16x2_t __attribute__((ext_vector_type(2)));
typedef float f32x2_t __attribute__((ext_vector_type(2)));
DEVI unsigned pack2(float a, float b) { const f32x2_t v = {a, b}; const bf16x2_t r = __builtin_convertvector(v, bf16x2_t); return __builtin_bit_cast(unsigned, r); }
DEVI uint2 pack4(f32x4 v) { uint2 r; r.x = pack2(v[0], v[1]); r.y = pack2(v[2], v[3]); return r; }
DEVI float silu_f(float v) { return v * __builtin_amdgcn_rcpf(1.f + __expf(-v)); }
DEVI float sigmoid_f(float v) { return __builtin_amdgcn_rcpf(1.f + __expf(-v)); }
DEVI float logsig_f(float x) { return fminf(x, 0.f) - __logf(1.f + __expf(-fabsf(x))); }
DEVI float softplus_f(float x) { return x > 20.f ? x : __logf(1.f + __expf(x)); }
DEVI float wave_sum(float v) {
#pragma unroll
    for (int o = 32; o >= 1; o >>= 1) v += __shfl_xor(v, o);
    return v;
}
DEVI bf16x8 ldsfrag(const bf16_t* base, int ld, int row, int k) { return *(const bf16x8*)(base + row * ld + k); }
DEVI f32x4 mfma16(bf16x8 a, bf16x8 b, f32x4 c) { return __builtin_amdgcn_mfma_f32_16x16x32_bf16(a, b, c, 0, 0, 0); }
DEVI void unpack8(bf16x8 v, float (&o)[8]) {
#pragma unroll
    for (int e = 0; e < 8; ++e) o[e] = bf2f((bf16_t)v[e]);
}
DEVI bf16x8 packf8(const float (&o)[8]) {
    typedef unsigned u32x4 __attribute__((ext_vector_type(4)));
    u32x4 r; r[0] = pack2(o[0], o[1]); r[1] = pack2(o[2], o[3]); r[2] = pack2(o[4], o[5]); r[3] = pack2(o[6], o[7]);
    return __builtin_bit_cast(bf16x8, r);
}
DEVI bf16_t f2bf1(float a) { return (bf16_t)(pack2(a, a) & 0xFFFFu); }
typedef short s16x4 __attribute__((ext_vector_type(4)));
template <int LD> DEVI bf16x8 tr_frag(const bf16_t* base, int s0, int c0, int l15, int lq) {
#ifdef TR_EMUL
    bf16x8 r;
#pragma unroll
    for (int e = 0; e < 8; ++e) r[e] = (short)base[(s0 + lq * 8 + e) * LD + c0 + l15];
    return r;
#else
    const bf16_t* a = base + (s0 + lq * 8 + (l15 >> 2)) * LD + c0 + 4 * (l15 & 3);
    const s16x4 lo = __builtin_amdgcn_ds_read_tr16_b64_v4i16((LAS s16x4*)a);
    const s16x4 hi = __builtin_amdgcn_ds_read_tr16_b64_v4i16((LAS s16x4*)(a + 4 * LD));
    return __builtin_shufflevector(lo, hi, 0, 1, 2, 3, 4, 5, 6, 7);
#endif
}
template <class WT> DEVI void conv2x8w(bf16x8 r0, bf16x8 r1, bf16x8 r2, bf16x8 r3, bool v0, bool v3, const WT& cw, bf16x8& o0, bf16x8& o1) {
    const bf16x8 zz = {0, 0, 0, 0, 0, 0, 0, 0};
    if (!v0) r0 = zz;
    if (!v3) r3 = zz;
    float a[8], b[8];
#pragma unroll
    for (int e = 0; e < 8; ++e) { const f32x4 w = cw[e];
        const float x0 = bf2f((bf16_t)r0[e]), x1 = bf2f((bf16_t)r1[e]), x2 = bf2f((bf16_t)r2[e]), x3 = bf2f((bf16_t)r3[e]);
        a[e] = silu_f(w[0] * x0 + w[1] * x1 + w[2] * x2 + w[3]); b[e] = silu_f(w[0] * x1 + w[1] * x2 + w[2] * x3 + w[3]); }
    o0 = packf8(a); o1 = packf8(b);
}
DEVI void conv2x8(bf16x8 r0, bf16x8 r1, bf16x8 r2, bf16x8 r3, bool v0, bool v3, const f32x4* cw, bf16x8& o0, bf16x8& o1) {
    const bf16x8 zz = {0, 0, 0, 0, 0, 0, 0, 0};
    if (!v0) r0 = zz;
    if (!v3) r3 = zz;
    float a[8], b[8];
#pragma unroll
    for (int e = 0; e < 8; ++e) { const f32x4 w = cw[e];
        const float x0 = bf2f((bf16_t)r0[e]), x1 = bf2f((bf16_t)r1[e]), x2 = bf2f((bf16_t)r2[e]), x3 = bf2f((bf16_t)r3[e]);
        a[e] = silu_f(w[0] * x0 + w[1] * x1 + w[2] * x2 + w[3]); b[e] = silu_f(w[0] * x1 + w[1] * x2 + w[2] * x3 + w[3]); }
    o0 = packf8(a); o1 = packf8(b);
}

namespace pg8 {
constexpr int BM = 256, BK = 64, HALF = 128, HTB = HALF * BK * 2, STAGE_BYTES = 8 * HTB, NXCD = 8, WGM = 8;
DEVI int lds_byte(int r, int c) { const int st = (r >> 4) * 2 + (c >> 5), rr = r & 15, cc = c & 31, ob = rr * 64 + cc * 2; return st * 1024 + (ob ^ (((ob >> 9) & 1) << 5)); }
DEVI void stage_rc(int b, int& R, int& C) { const int st = b / 1024, sb = b % 1024, swz = sb ^ (((sb >> 9) & 1) << 5); R = (st >> 1) * 16 + swz / 64; C = (st & 1) * 32 + (swz % 64) / 2; }
struct Unit { int pm, pn; };
struct Gemm { const bf16_t* A; const bf16_t* Bt; int M, N, K; int split, off0, off1; };
struct StaticOrder {
    int nM, nN, nwg, G, c;
    DEVI void init(int M, int N, int G_, int c_) { nM = M / BM; nN = N / BM; nwg = nM * nN; G = G_; c = c_; }
    DEVI bool next(int i, Unit& u) const {
        const long L = (long)i * G + c; if (L >= nwg) return false;
        int wgid = (int)L; { const int q = nwg / NXCD, r = nwg % NXCD, xcd = wgid % NXCD, off = wgid / NXCD; wgid = (xcd < r ? xcd * (q + 1) : r * (q + 1) + (xcd - r) * q) + off; }
        const int nig = WGM * nN, gid = wgid / nig, fm = gid * WGM, gsz = (nM - fm) < WGM ? (nM - fm) : WGM;
        u.pm = fm + ((wgid % nig) % gsz); u.pn = (wgid % nig) / gsz; return true;
    }
};

template <class Epi>
DEVI void gemm_phase(LAS unsigned char* lds, const Gemm g, const StaticOrder& S, const Epi& E) {
    const int tid = tid_l(), wid = __builtin_amdgcn_readfirstlane(tid >> 6), lane = tid & 63, wr = wid >> 2, wc = wid & 3, fr = lane & 15, fq = lane >> 4;
    const int K = g.K, nt = K / BK;
    unsigned voffA[2];
#pragma unroll
    for (int i = 0; i < 2; ++i) { int R, C; stage_rc(tid * 16 + i * 8192, R, C); voffA[i] = (unsigned)(R * K + C) * 2u; }
    const size_t kstep = (size_t)(BK * 2);
    const size_t hstep = (size_t)HALF * K * 2;
    const size_t tstep = 2 * hstep;
    const unsigned ldsw = (unsigned)wid * 1024u;
    const int aoff = lds_byte(wr * 64 + fr, fq * 8), boff = lds_byte(wc * 32 + fr, fq * 8);
#define PG8_SA(b, h) (((b) * 2 + (h)) * HTB)
#define PG8_SB(b, h) ((4 + (b) * 2 + (h)) * HTB)
#define PG8_STAGE(bufoff, gbase) do { _Pragma("unroll") for (int _i = 0; _i < 2; ++_i) \
        __builtin_amdgcn_global_load_lds((const unsigned*)((const char*)(gbase) + voffA[_i]), (LAS unsigned*)(lds + (bufoff) + ldsw + _i * 8192), 16, 0, 0); } while (0)
#define PG8_LDA(dst, b, h) do { _Pragma("unroll") for (int m = 0; m < 4; ++m) _Pragma("unroll") for (int k = 0; k < 2; ++k) dst[m][k] = *(const LAS bf16x8*)(lds + PG8_SA(b, h) + aoff + m * 2048 + k * 1024); } while (0)
#define PG8_LDB(dst, b, h) do { _Pragma("unroll") for (int n = 0; n < 2; ++n) _Pragma("unroll") for (int k = 0; k < 2; ++k) dst[n][k] = *(const LAS bf16x8*)(lds + PG8_SB(b, h) + boff + n * 2048 + k * 1024); } while (0)
#define PG8_MMA(ai, bj, At, Bt) do { __builtin_amdgcn_s_setprio(1); _Pragma("unroll") for (int m = 0; m < 4; ++m) _Pragma("unroll") for (int n = 0; n < 2; ++n) _Pragma("unroll") for (int k = 0; k < 2; ++k) \
        acc[ai][bj][m][n] = __builtin_amdgcn_mfma_f32_16x16x32_bf16(Bt[n][k], At[m][k], acc[ai][bj][m][n], 0, 0, 0); __builtin_amdgcn_s_setprio(0); } while (0)
#define PG8_WAIT_V(n) asm volatile("s_waitcnt vmcnt(" #n ")" ::: "memory")
#define PG8_WAIT_L(n) asm volatile("s_waitcnt lgkmcnt(" #n ")" ::: "memory")
#define PG8_BAR __builtin_amdgcn_s_barrier()
#define PG8_SCHED __builtin_amdgcn_sched_barrier(0)
#define PG8_PHYS(pm) ((pm) < g.split ? (pm) + g.off0 : (pm) - g.split + g.off1)
    Unit cur, nxt; int ui = 0;
    if (!S.next(0, cur)) return;
    f32x4 acc[2][2][4][2];
#pragma unroll
    for (int a = 0; a < 2; ++a)
#pragma unroll
        for (int b = 0; b < 2; ++b)
#pragma unroll
            for (int m = 0; m < 4; ++m)
#pragma unroll
                for (int n = 0; n < 2; ++n) acc[a][b][m][n] = (f32x4){0.f, 0.f, 0.f, 0.f};
    bf16x8 At[4][2], B0[2][2], B1[2][2];
    const char* cA = (const char*)g.A + (size_t)PG8_PHYS(cur.pm) * tstep; const char* cB = (const char*)g.Bt + (size_t)cur.pn * tstep;
    PG8_STAGE(PG8_SB(0, 0), cB); PG8_STAGE(PG8_SA(0, 0), cA); PG8_STAGE(PG8_SB(0, 1), cB + hstep); PG8_STAGE(PG8_SA(0, 1), cA + hstep);
    if (wr == 1) PG8_BAR;
    PG8_WAIT_V(4); PG8_BAR;
    PG8_STAGE(PG8_SB(1, 0), cB + kstep); PG8_STAGE(PG8_SA(1, 0), cA + kstep); PG8_STAGE(PG8_SB(1, 1), cB + hstep + kstep);
    PG8_WAIT_V(6); PG8_BAR;
    for (;;) {
        const bool has_next = S.next(ui + 1, nxt);
        const char* nA = has_next ? (const char*)g.A + (size_t)PG8_PHYS(nxt.pm) * tstep : cA; const char* nB = has_next ? (const char*)g.Bt + (size_t)nxt.pn * tstep : cB;
        for (int t = 0; t < nt; t += 2) {
            const bool last = (t == nt - 2);
            const char* a1 = cA + (size_t)(t + 1) * kstep;
            const char* a2 = last ? nA : cA + (size_t)(t + 2) * kstep; const char* b2 = last ? nB : cB + (size_t)(t + 2) * kstep;
            const char* a3 = a2 + kstep; const char* b3 = b2 + kstep;
            PG8_LDB(B0, 0, 0); PG8_SCHED; PG8_LDA(At, 0, 0); PG8_STAGE(PG8_SA(1, 1), a1 + hstep);
            PG8_WAIT_L(8); PG8_BAR; PG8_WAIT_L(0); PG8_MMA(0, 0, At, B0); PG8_BAR; PG8_SCHED;
            PG8_LDB(B1, 0, 1); PG8_STAGE(PG8_SB(0, 0), b2);
            PG8_BAR; PG8_WAIT_L(0); PG8_MMA(0, 1, At, B1); PG8_BAR;
            PG8_LDA(At, 0, 1); PG8_STAGE(PG8_SA(0, 0), a2);
            PG8_BAR; PG8_WAIT_L(0); PG8_MMA(1, 0, At, B0); PG8_BAR; PG8_SCHED;
            PG8_STAGE(PG8_SB(0, 1), b2 + hstep);
            PG8_WAIT_V(6); PG8_BAR; PG8_MMA(1, 1, At, B1); PG8_BAR;
            PG8_LDB(B0, 1, 0); PG8_SCHED; PG8_LDA(At, 1, 0); PG8_STAGE(PG8_SA(0, 1), a2 + hstep);
            PG8_WAIT_L(8); PG8_BAR; PG8_WAIT_L(0); PG8_MMA(0, 0, At, B0); PG8_BAR; PG8_SCHED;
            PG8_LDB(B1, 1, 1); PG8_STAGE(PG8_SB(1, 0), b3);
            PG8_BAR; PG8_WAIT_L(0); PG8_MMA(0, 1, At, B1); PG8_BAR;
            PG8_LDA(At, 1, 1); PG8_STAGE(PG8_SA(1, 0), a3);
            PG8_BAR; PG8_WAIT_L(0); PG8_MMA(1, 0, At, B0); PG8_BAR; PG8_SCHED;
            PG8_STAGE(PG8_SB(1, 1), b3 + hstep);
            PG8_WAIT_V(6); PG8_BAR; PG8_MMA(1, 1, At, B1); PG8_BAR;
        }
        { int tid2 = tid_l(); const int wid2 = tid2 >> 6, lane2 = tid2 & 63; E(acc, cur, wid2 >> 2, wid2 & 3, lane2 & 15, lane2 >> 4); }
        if (!has_next) break;
#pragma unroll
        for (int a = 0; a < 2; ++a)
#pragma unroll
            for (int b = 0; b < 2; ++b)
#pragma unroll
                for (int m = 0; m < 4; ++m)
#pragma unroll
                    for (int n = 0; n < 2; ++n) acc[a][b][m][n] = (f32x4){0.f, 0.f, 0.f, 0.f};
        cur = nxt; cA = nA; cB = nB; ++ui;
    }
    PG8_WAIT_V(0);
    if (wr == 0) PG8_BAR;
    PG8_BAR;
#undef PG8_SA
#undef PG8_SB
#undef PG8_STAGE
#undef PG8_LDA
#undef PG8_LDB
#undef PG8_MMA
#undef PG8_WAIT_V
#undef PG8_WAIT_L
#undef PG8_BAR
#undef PG8_SCHED
#undef PG8_PHYS
}
}
using pg8::Unit;

struct EpiBf16 {
    bf16_t* O; int ldc;
    DEVI void operator()(const f32x4 (&acc)[2][2][4][2], const Unit& u, int wr, int wc, int fr, int fq) const {
        const int row0 = u.pm * 256 + wr * 64 + fr, col0 = u.pn * 256 + wc * 32 + 8 * fq;
#pragma unroll
        for (int ai = 0; ai < 2; ++ai)
#pragma unroll
            for (int m = 0; m < 4; ++m) { bf16_t* rowp = O + (size_t)(row0 + ai * 128 + m * 16) * ldc + col0;
#pragma unroll
                for (int bj = 0; bj < 2; ++bj) { const uint2 a = pack4(acc[ai][bj][m][0]), b = pack4(acc[ai][bj][m][1]);
                    *(uint4*)(rowp + bj * 128) = make_uint4(a.x, a.y, b.x, b.y); } }
    }
};
struct EpiInL0 {
    bf16_t* P; float* F; bf16_t* R2raw;
    DEVI void operator()(const f32x4 (&acc)[2][2][4][2], const Unit& u, int wr, int wc, int fr, int fq) const {
        const int row0 = u.pm * 256 + wr * 64 + fr;
        if (u.pn >= 6 && u.pn < 10) { EpiBf16 e{R2raw, 1024}; Unit v = u; v.pn -= 6; e(acc, v, wr, wc, fr, fq); return; }
        if (u.pn < 14) { EpiBf16 e{P, PLD}; e(acc, u, wr, wc, fr, fq); return; }
        const int c0 = wc * 32 + 4 * fq;
#pragma unroll
        for (int ai = 0; ai < 2; ++ai)
#pragma unroll
            for (int m = 0; m < 4; ++m) { float* rowp = F + (size_t)(row0 + ai * 128 + m * 16) * FLD;
#pragma unroll
                for (int n = 0; n < 2; ++n) { const int c = c0 + n * 16; if (c < 48) *(f32x4*)(rowp + c) = acc[ai][0][m][n]; } }
    }
};
struct EpiInL1 {
    bf16_t* X; bf16_t* Z; float* DT;
    DEVI void operator()(const f32x4 (&acc)[2][2][4][2], const Unit& u, int wr, int wc, int fr, int fq) const {
        if (u.pn < 12) { EpiBf16 e{X, 3072}; e(acc, u, wr, wc, fr, fq); return; }
        if (u.pn < 20) { if (u.pm < 64) { EpiBf16 e{Z, 2048}; Unit v = u; v.pn -= 12; e(acc, v, wr, wc, fr, fq); } return; }
        const int row0 = u.pm * 256 + wr * 64 + fr, c0 = wc * 32 + 4 * fq;
#pragma unroll
        for (int ai = 0; ai < 2; ++ai)
#pragma unroll
            for (int m = 0; m < 4; ++m) { float* rowp = DT + (size_t)(row0 + ai * 128 + m * 16) * 64;
#pragma unroll
                for (int n = 0; n < 2; ++n) { const int c = c0 + n * 16; if (c < 64) *(f32x4*)(rowp + c) = acc[ai][0][m][n]; } }
    }
};
struct EpiResid {
    float* XL; float* XC; const float* mod; int goff; int rowbase;
    DEVI void operator()(const f32x4 (&acc)[2][2][4][2], const Unit& u, int wr, int wc, int fr, int fq) const {
        const int grow_t = __builtin_amdgcn_readfirstlane(rowbase + u.pm * 256);
        const bool isc = grow_t >= MLAT;
        const int bidx = isc ? 16 : (grow_t >> 11);
        float* X = isc ? XC + (size_t)(grow_t - MLAT) * DM : XL + (size_t)grow_t * DM;
        const float* gate = mod + (size_t)bidx * 6144 + goff + u.pn * 256;
        X += u.pn * 256;
        const unsigned r0 = wr * 64 + fr, c0 = wc * 32 + 8 * fq;
        f32x4 gv[2][2];
#pragma unroll
        for (int bj = 0; bj < 2; ++bj)
#pragma unroll
            for (int n = 0; n < 2; ++n) gv[bj][n] = *(const f32x4*)(gate + c0 + bj * 128 + n * 4);
#pragma unroll
        for (int ai = 0; ai < 2; ++ai) {
            f32x4 rv[4][2][2];
#pragma unroll
            for (int m = 0; m < 4; ++m) { const unsigned ro = (r0 + ai * 128 + m * 16) * DM + c0;
#pragma unroll
                for (int bj = 0; bj < 2; ++bj)
#pragma unroll
                    for (int n = 0; n < 2; ++n) rv[m][bj][n] = *(const f32x4*)(X + ro + bj * 128 + n * 4); }
#pragma unroll
            for (int m = 0; m < 4; ++m) { const unsigned ro = (r0 + ai * 128 + m * 16) * DM + c0;
#pragma unroll
                for (int bj = 0; bj < 2; ++bj)
#pragma unroll
                    for (int n = 0; n < 2; ++n) *(f32x4*)(X + ro + bj * 128 + n * 4) = rv[m][bj][n] + gv[bj][n] * acc[ai][bj][m][n]; }
            __builtin_amdgcn_sched_barrier(0); }
    }
};

template <class Epi>
DEVI void run_gemm(unsigned char* shm, const bf16_t* A, const bf16_t* Bt, int M, int N, int K, const Epi& E, int split = 1 << 30, int off0 = 0, int off1 = 0, int nblk = 0) {
    pg8::Gemm g{A, Bt, M, N, K, split, off0, off1};
    pg8::StaticOrder S; S.init(M, N, nblk ? nblk : (int)gridDim.x, (int)bid_l());
    pg8::gemm_phase<Epi>((LAS unsigned char*)shm, g, S, E);
}

DEVI int perm32(int rho) { const int n = rho >> 4, i = rho & 15; return 8 * (i >> 2) + 4 * n + (i & 3); }
DEVI void wsrc_col(const Params& p, int m, int n, const float*& ptr, long& stride) {
    ptr = nullptr; stride = 0;
    if ((m == 0 && n < 3584) || m == 2 || m == 6 || (m == 4 && n < 5120) || m == 1 || m == 3 || m == 5 || m == 7) n = (n & ~31) + perm32(n & 31);
    switch (m) {
    case 0: if (n < 3600) { ptr = INP(13) + n; stride = 3600; } else if (n < 3632) { const int d = (n - 3600) >> 4, r = (n - 3600) & 15; ptr = INP(14) + d * 16384 + r; stride = 16; } break;
    case 1: ptr = INP(22) + n; stride = 1024; break;
    case 2: case 6: { const int g = n < 2048 ? 0 : (n < 4096 ? 1 : 2); const int base = g * 2048, w = g == 2 ? 768 : 1024, j0 = g * 1024, o = n - base;
        const int col = o < w ? j0 + o : 2816 + j0 + (o - w); ptr = INP(9) + (size_t)(m == 6 ? 1 : 0) * 1024 * NUP + col; stride = NUP; } break;
    case 3: case 7: ptr = INP(12) + (size_t)(m == 7 ? 1 : 0) * DFF * 1024 + n; stride = 1024; break;
    case 4: if (n < 5184) { const int col = n < 3072 ? 2048 + n : (n < 5120 ? n - 3072 : n); ptr = INP(23) + col; stride = 5184; } break;
    case 5: ptr = INP(30) + n; stride = 1024; break;
    }
}
DEVI void phase_prep(const Params& p, unsigned char* shm) {
    bf16_t* Wb = (bf16_t*)(WSP() + OFF_W);
    float* tile = (float*)shm;
    const int tid = tid_l();
    const int nbk[8] = {60 * 4, 16 * 4, 88 * 4, 16 * 11, 84 * 4, 16 * 8, 88 * 4, 16 * 11};
    const int kb_[8] = {4, 4, 4, 11, 4, 8, 4, 11};
    const size_t woff[8] = {W0IN, W0OUT, UP0, DN0, W1IN, W1OUT, UP1, DN1};
    int total = 0;
#pragma unroll
    for (int i = 0; i < 8; ++i) total += nbk[i];
    for (int u = bid_l(); u < total; u += gridDim.x) {
        int m = 0, r = u;
#pragma unroll
        for (int i = 0; i < 8; ++i) { if (m == i && r >= nbk[i]) { r -= nbk[i]; m = i + 1; } }
        int kbn = 4; size_t wo = 0;
#pragma unroll
        for (int i = 0; i < 8; ++i) if (m == i) { kbn = kb_[i]; wo = woff[i]; }
        const int nblk = r / kbn, kblk = r % kbn, K = kbn * 256;
        const int n0 = nblk * 64, k0 = kblk * 256;
        const float* cp; long cs; wsrc_col(p, m, n0 + (tid & 63), cp, cs);
        __syncthreads();
        float ld_[32];
#pragma unroll
        for (int i = 0; i < 32; ++i) { const int k = i * 8 + (tid >> 6); ld_[i] = cp ? cp[(size_t)(k0 + k) * cs] : 0.f; }
#pragma unroll
        for (int i = 0; i < 32; ++i) { const int k = i * 8 + (tid >> 6); tile[k * 65 + (tid & 63)] = ld_[i]; }
        __syncthreads();
#pragma unroll
        for (int q = 0; q < 4; ++q) { const int n = tid >> 3, kq = q * 64 + (tid & 7) * 8; float v[8];
#pragma unroll
          for (int e = 0; e < 8; ++e) v[e] = tile[(kq + e) * 65 + n];
          *(bf16x8*)(Wb + wo + (size_t)(n0 + n) * K + k0 + kq) = packf8(v); }
    }
    __syncthreads();
    float* sc = (float*)shm;
    float* red = sc + 17 * 1024;
    const int nmu = 2 * 192;
    if ((int)bid_l() < nmu) {
        for (int i = tid; i < 17 * 1024; i += 512) { const int v = i >> 10, k = i & 1023; const float c = v < 16 ? INP(1)[v * 1024 + k] : INP(3)[k]; sc[i] = silu_f(c); }
        __syncthreads();
        float* MOD = (float*)(WSP() + OFF_MOD);
        for (int u = (int)gridDim.x - 1 - (int)bid_l(); u < nmu; u += gridDim.x) {
            const int layer = u / 192, cb = (u % 192) * 32, col = tid & 31, kg = tid >> 5;
            const float* w = INP(4) + (size_t)layer * 1024 * 6144 + cb + col;
            float a[17];
#pragma unroll
            for (int v = 0; v < 17; ++v) a[v] = 0.f;
            for (int k0 = kg * 64; k0 < kg * 64 + 64; k0 += 16) { float wv[16];
#pragma unroll
                for (int q = 0; q < 16; ++q) wv[q] = w[(size_t)(k0 + q) * 6144];
#pragma unroll
                for (int q = 0; q < 16; ++q) {
#pragma unroll
                    for (int v = 0; v < 17; ++v) a[v] += sc[v * 1024 + k0 + q] * wv[q]; } }
#pragma unroll
            for (int v = 0; v < 17; ++v) red[(kg * 17 + v) * 32 + col] = a[v];
            __syncthreads();
            for (int i = tid; i < 17 * 32; i += 512) { const int v = i >> 5, c = i & 31; float s = INP(5)[layer * 6144 + cb + c];
#pragma unroll
                for (int q = 0; q < 16; ++q) s += red[(q * 17 + v) * 32 + c];
                MOD[((size_t)layer * 17 + v) * 6144 + cb + c] = s; }
            __syncthreads();
        }
    }
}

DEVI void phase_modulate(const Params& p, const float* srcL, const float* srcC, int nrows, const float* g, int layer, int soff, float* cpL = nullptr, float* cpC = nullptr, int rbeg = 0, int b0 = 0) {
    const int tid_ = tid_l(); const int wid = tid_ >> 6, lane = tid_ & 63;
    bf16_t* H = (bf16_t*)(WSP() + OFF_H);
    const float* MOD = (const float*)(WSP() + OFF_MOD) + (size_t)layer * 17 * 6144;
    const int nw = ((int)gridDim.x - b0) * 8, rpw = (nrows - rbeg + nw - 1) / nw;
    if ((int)bid_l() < b0) return;
    int row = rbeg + ((bid_l() - b0) * 8 + wid) * rpw;
    const int rend = min(row + rpw, nrows);
    f32x4 v[4], nv[4], gs[4], sh[4];
#pragma unroll
    for (int i = 0; i < 4; ++i) { gs[i] = (f32x4){0.f, 0.f, 0.f, 0.f}; sh[i] = gs[i]; }
    int cur_b = -1;
    auto loadrow = [&](int r, f32x4 (&d)[4]) { const bool isc = r >= MLAT; const float* src = isc ? srcC + (size_t)(r - MLAT) * DM : srcL + (size_t)r * DM;
#pragma unroll
        for (int i = 0; i < 4; ++i) d[i] = *(const f32x4*)(src + i * 256 + lane * 4); };
    if (row < rend) loadrow(row, v);
    for (; row < rend; ++row) {
        const bool isc = row >= MLAT;
        if (row + 1 < rend) loadrow(row + 1, nv);
        const int b = isc ? 16 : (row >> 11);
        if (b != cur_b) { cur_b = b; const float* md = MOD + (size_t)b * 6144 + soff;
#pragma unroll
            for (int i = 0; i < 4; ++i) { const int c = i * 256 + lane * 4; const f32x4 gg = *(const f32x4*)(g + c), sc = *(const f32x4*)(md + 1024 + c); sh[i] = *(const f32x4*)(md + c); gs[i] = gg * (sc + 1.f); } }
        float ss = 0.f;
#pragma unroll
        for (int i = 0; i < 4; ++i) ss += v[i][0] * v[i][0] + v[i][1] * v[i][1] + v[i][2] * v[i][2] + v[i][3] * v[i][3];
        ss = wave_sum(ss);
        if (cpL) { float* cp = isc ? cpC + (size_t)(row - MLAT) * DM : cpL + (size_t)row * DM;
#pragma unroll
            for (int i = 0; i < 4; ++i) *(f32x4*)(cp + i * 256 + lane * 4) = v[i]; }
        const float rstd = rsqrtf(ss * (1.f / 1024.f) + 1e-6f);
#pragma unroll
        for (int i = 0; i < 4; ++i) { const int c = i * 256 + lane * 4;
            *(uint2*)(H + (size_t)row * DM + c) = pack4(v[i] * rstd * gs[i] + sh[i]); }
#pragma unroll
        for (int i = 0; i < 4; ++i) v[i] = nv[i];
    }
}
DEVI void phase_final_norm(const Params& p) {
    const int tid_ = tid_l(); const int wid = tid_ >> 6, lane = tid_ & 63;
    const float* g = INP(8);
    float* X = OUTP();
    const int stride = gridDim.x * 8;
    int row = bid_l() * 8 + wid;
    f32x4 v[4], nv[4], gg[4];
#pragma unroll
    for (int i = 0; i < 4; ++i) gg[i] = *(const f32x4*)(g + i * 256 + lane * 4);
    if (row < MLAT) {
#pragma unroll
        for (int i = 0; i < 4; ++i) v[i] = *(const f32x4*)(X + (size_t)row * DM + i * 256 + lane * 4); }
    for (; row < MLAT; row += stride) {
        if (row + stride < MLAT) {
#pragma unroll
            for (int i = 0; i < 4; ++i) nv[i] = *(const f32x4*)(X + (size_t)(row + stride) * DM + i * 256 + lane * 4); }
        float ss = 0.f;
#pragma unroll
        for (int i = 0; i < 4; ++i) ss += v[i][0] * v[i][0] + v[i][1] * v[i][1] + v[i][2] * v[i][2] + v[i][3] * v[i][3];
        ss = wave_sum(ss);
        const float rstd = rsqrtf(ss * (1.f / 1024.f) + 1e-6f);
#pragma unroll
        for (int i = 0; i < 4; ++i) *(f32x4*)(X + (size_t)row * DM + i * 256 + lane * 4) = v[i] * rstd * gg[i];
#pragma unroll
        for (int i = 0; i < 4; ++i) v[i] = nv[i];
    }
}

template <int N>
DEVI void conv_silu(const bf16_t* src, int ld, int pos0, int seqlen, float w0, float w1, float w2, float bias, float (&out)[N]) {
    const bool has_prev = pos0 >= 1, has_next = pos0 + N < seqlen;
    bf16_t raw[N + 2];
    raw[0] = src[has_prev ? -(long)ld : 0];
#pragma unroll
    for (int i = 0; i < N; ++i) raw[i + 1] = src[(size_t)i * ld];
    raw[N + 1] = src[(size_t)(has_next ? N : N - 1) * ld];
    float prev = has_prev ? bf2f(raw[0]) : 0.f;
    float cur = bf2f(raw[1]);
#pragma unroll
    for (int i = 0; i < N; ++i) {
        const float nxt = (i + 1 < N) ? bf2f(raw[i + 2]) : (has_next ? bf2f(raw[N + 1]) : 0.f);
        out[i] = silu_f(w0 * prev + w1 * cur + w2 * nxt + bias);
        prev = cur; cur = nxt;
    }
}
template <int N>
DEVI void store_row_t(bf16_t* dst, const float (&v)[N]) {
#pragma unroll
    for (int q = 0; q < N / 8; ++q) { bf16x8 r;
#pragma unroll
        for (int e = 0; e < 8; ++e) r[e] = (short)f2bf(v[q * 8 + e]);
        *(bf16x8*)(dst + q * 8) = r; }
}
DEVI void chain_chunk(int b, int dir, int step, int& row0, int& pos0, int& seqlen, bool& is_ctx) {
    if (step < 4) { const int c = dir ? 3 - step : step; is_ctx = true; pos0 = c * 64; seqlen = TC; row0 = MLAT + b * TC + pos0; }
    else { const int c = dir ? 31 - (step - 4) : (step - 4); is_ctx = false; pos0 = c * 64; seqlen = TL; row0 = b * TL + pos0; }
}

DEVI void gla_chain(const Params& p, int b, int h, int dir, unsigned char* shm) {
    bf16_t* sQ = (bf16_t*)shm;
    bf16_t* sK = sQ + 64 * 72;
    bf16_t* sKe = sK + 64 * 72;
    bf16_t* sVt = sKe + 64 * 72;
    bf16_t* sAt = sVt + 128 * 72;
    bf16_t* sSt = sAt + 64 * 72;
    float* sSeg = (float*)(sSt + 128 * 72);
    float* sR = sSeg + 8 * 64;
    float* sDec = sR + 64 * 16;
    const int tid = tid_l(), wid = tid >> 6, lane = tid & 63, l15 = lane & 15, lq = lane >> 4;
    const bf16_t* P = (const bf16_t*)(WSP() + OFF_P);
    const float* F = (const float*)(WSP() + OFF_F32);
    bf16_t* R1 = (bf16_t*)(WSP() + OFF_H);
    const int k = lane, tg = wid;
    float a2v[16];
#pragma unroll
    for (int r = 0; r < 16; ++r) a2v[r] = INP(15)[(dir * 16 + r) * 256 + h * 64 + k];
    const float abv = INP(16)[dir * 256 + h * 64 + k];
    f32x4 S[4];
#pragma unroll
    for (int i = 0; i < 4; ++i) S[i] = (f32x4){0.f, 0.f, 0.f, 0.f};
    __syncthreads();
    for (int i = tid; i < 128 * 72 / 2; i += 512) ((unsigned*)sSt)[i] = 0u;
    bf16_t qraw[8], kraw[8], vraw[16]; float2 rr;
    auto issue = [&](int step) {
        int row0, pos0, seqlen; bool ic; chain_chunk(b, dir, step, row0, pos0, seqlen, ic);
        { const int idx = tid * 2, t = idx >> 4, r = idx & 15; rr = *(const float2*)(F + (size_t)(row0 + t) * FLD + 16 + dir * 16 + r); }
#pragma unroll
        for (int j = 0; j < 8; ++j) { const int t = tg * 8 + j; qraw[j] = P[(size_t)(row0 + t) * PLD + h * 64 + k]; kraw[j] = P[(size_t)(row0 + t) * PLD + 256 + h * 64 + k]; }
        { const int v = tid & 127, tq = tid >> 7;
#pragma unroll
          for (int j = 0; j < 16; ++j) vraw[j] = P[(size_t)(row0 + tq * 16 + j) * PLD + 512 + h * 128 + v]; } };
    issue(0);
    { const int idx = tid * 2, t = idx >> 4, r = idx & 15; sR[t * 16 + r] = rr.x; sR[t * 16 + r + 1] = rr.y; }
    __syncthreads();
    for (int step = 0; step < 36; ++step) {
        int row0, pos0, seqlen; bool is_ctx; chain_chunk(b, dir, step, row0, pos0, seqlen, is_ctx);
        float cl[8];
        {
            float la[8];
#pragma unroll
            for (int j = 0; j < 8; ++j) { const int t = tg * 8 + j; float x = abv;
#pragma unroll
                for (int r = 0; r < 16; ++r) x += sR[t * 16 + r] * a2v[r];
                la[j] = logsig_f(x) * (1.f / 16.f); }
            if (!dir) { float s = 0.f;
#pragma unroll
                for (int j = 0; j < 8; ++j) { s += la[j]; cl[j] = s; }
                sSeg[tg * 64 + k] = s; }
            else { float s = 0.f;
#pragma unroll
                for (int j = 7; j >= 0; --j) { s += la[j]; cl[j] = s; }
                sSeg[tg * 64 + k] = s; }
        }
        __syncthreads();
        {
            float off = 0.f, tot = 0.f;
#pragma unroll
            for (int q = 0; q < 8; ++q) { const float sv = sSeg[q * 64 + k]; tot += sv; if (dir ? (q > tg) : (q < tg)) off += sv; }
            if (tg == 0) sDec[k] = __expf(tot);
            float ke[8];
#pragma unroll
            for (int j = 0; j < 8; ++j) { const int t = tg * 8 + j; const float cum = cl[j] + off;
                const float qv = bf2f(qraw[j]), kv = bf2f(kraw[j]);
                sQ[t * 72 + k] = f2bf1(qv * __expf(cum) * 0.125f);
                sK[t * 72 + k] = f2bf1(kv * __expf(-cum));
                ke[j] = kv * __expf(tot - cum); }
            store_row_t<8>(sKe + k * 72 + tg * 8, ke);
            const int v = tid & 127, tq = tid >> 7; float vv[16];
#pragma unroll
            for (int j = 0; j < 16; ++j) vv[j] = bf2f(vraw[j]);
            store_row_t<16>(sVt + v * 72 + tq * 16, vv);
            if (step + 1 < 36) issue(step + 1);
        }
        __syncthreads();
        { const int tm = wid >> 1;
#pragma unroll
          for (int q = 0; q < 2; ++q) { const int tn = (wid & 1) * 2 + q; f32x4 acc = (f32x4){0.f, 0.f, 0.f, 0.f};
#pragma unroll
              for (int kk = 0; kk < 64; kk += 32) acc = mfma16(ldsfrag(sQ, 72, tm * 16 + l15, kk + lq * 8), ldsfrag(sK, 72, tn * 16 + l15, kk + lq * 8), acc);
              const int s = tn * 16 + l15;
#pragma unroll
              for (int r = 0; r < 4; ++r) { const int t = tm * 16 + lq * 4 + r; const bool keep = dir ? (s >= t) : (s <= t); sAt[t * 72 + s] = f2bf1(keep ? acc[r] : 0.f); } } }
        __syncthreads();
#pragma unroll
        for (int tm = 0; tm < 4; ++tm) { f32x4 acc = (f32x4){0.f, 0.f, 0.f, 0.f};
#pragma unroll
            for (int kk = 0; kk < 64; kk += 32) acc = mfma16(ldsfrag(sAt, 72, tm * 16 + l15, kk + lq * 8), ldsfrag(sVt, 72, wid * 16 + l15, kk + lq * 8), acc);
#pragma unroll
            for (int kk = 0; kk < 64; kk += 32) acc = mfma16(ldsfrag(sQ, 72, tm * 16 + l15, kk + lq * 8), ldsfrag(sSt, 72, wid * 16 + l15, kk + lq * 8), acc);
#pragma unroll
            for (int r = 0; r < 4; ++r) { const int t = tm * 16 + lq * 4 + r; R1[(size_t)(row0 + t) * 1024 + dir * 512 + h * 128 + wid * 16 + l15] = f2bf1(acc[r]); } }
#pragma unroll
        for (int kb = 0; kb < 4; ++kb) {
#pragma unroll
            for (int r = 0; r < 4; ++r) S[kb][r] *= sDec[kb * 16 + lq * 4 + r];
#pragma unroll
            for (int kk = 0; kk < 64; kk += 32) S[kb] = mfma16(ldsfrag(sKe, 72, kb * 16 + l15, kk + lq * 8), ldsfrag(sVt, 72, wid * 16 + l15, kk + lq * 8), S[kb]);
            *(uint2*)(sSt + (wid * 16 + l15) * 72 + kb * 16 + lq * 4) = pack4(S[kb]); }
        if (step + 1 < 36) { const int idx = tid * 2, t = idx >> 4, r = idx & 15; sR[t * 16 + r] = rr.x; sR[t * 16 + r + 1] = rr.y; }
        __syncthreads();
    }
}

DEVI void phase_ml_conv(const Params& p, unsigned char* shm) {
    f32x4* sCwAll = (f32x4*)shm;
    const int tid = tid_l();
    const bf16_t* RAW = (const bf16_t*)(WSP() + OFF_R2);
    bf16_t* P = (bf16_t*)(WSP() + OFF_P);
    { const float* cw = INP(17); const float* cb = INP(18);
      for (int i = tid; i < 1024; i += 512) sCwAll[i] = (f32x4){cw[i], cw[1024 + i], cw[2048 + i], cb[i]}; }
    __syncthreads();
    const int ntask = (MTOT / 2) * 128;
    for (int i = bid_l() * 512 + tid; i < ntask; i += gridDim.x * 512) {
        const int v = i & 127, pr = i >> 7, r0 = pr * 2;
        int pos, seqlen;
        if (r0 < MLAT) { pos = r0 & (TL - 1); seqlen = TL; } else { pos = (r0 - MLAT) & (TC - 1); seqlen = TC; }
        const bool v0 = pos >= 1, v3 = pos + 2 < seqlen;
        const bf16_t* base = RAW + (size_t)r0 * 1024 + v * 8;
        const long om = v0 ? -1024l : 0l, o3 = v3 ? 2048l : 1024l;
        const bf16x8 a0 = *(const bf16x8*)(base + om), a1 = *(const bf16x8*)(base), a2 = *(const bf16x8*)(base + 1024), a3 = *(const bf16x8*)(base + o3);
        bf16x8 oa, ob; conv2x8(a0, a1, a2, a3, v0, v3, sCwAll + v * 8, oa, ob);
        if (v >= 64) { float x[8], y[8]; unpack8(oa, x); unpack8(ob, y);
#pragma unroll
            for (int e = 0; e < 8; ++e) { x[e] *= 0.08838834764831845f; y[e] *= 0.08838834764831845f; }
            oa = packf8(x); ob = packf8(y); }
        *(bf16x8*)(P + (size_t)r0 * PLD + 1536 + v * 8) = oa; *(bf16x8*)(P + (size_t)(r0 + 1) * PLD + 1536 + v * 8) = ob;
    }
}

DEVI void mlstm_chain(const Params& p, int b, int h, int dir, unsigned char* shm) {
    bf16_t* sQ = (bf16_t*)shm;
    bf16_t* sK = sQ + 64 * 136;
    bf16_t* sV = sK + 64 * 136;
    bf16_t* sH = sV + 64 * 136;
    bf16_t* sSc = sH + 64 * 136;
    bf16_t* sCt = sSc + 64 * 72;
    float* sRow = (float*)(sCt + 144 * 136);
    float* sU = sRow + 64;
    float* sAw = sU + 64;
    float* sWs = sAw + 64;
    float* sEmt = sWs + 64;
    float* sDen = sEmt + 64;
    float* sScal = sDen + 64;
    f32x4* sCw = (f32x4*)(sScal + 4);
    const int tid = tid_l(), wid = tid >> 6, lane = tid & 63, l15 = lane & 15, lq = lane >> 4;
    const bf16_t* P = (const bf16_t*)(WSP() + OFF_P);
    const float* F = (const float*)(WSP() + OFF_F32);
    bf16_t* R2 = (bf16_t*)(WSP() + OFF_R2);
    const int vc = tid & 15, tp = tid >> 4;
    const float gb_i = INP(19)[(dir * 2) * 4 + h], gb_f = INP(19)[(dir * 2 + 1) * 4 + h];
    f32x4 C[8], Cn;
#pragma unroll
    for (int i = 0; i < 8; ++i) C[i] = (f32x4){0.f, 0.f, 0.f, 0.f};
    Cn = (f32x4){0.f, 0.f, 0.f, 0.f};
    float mcar = 0.f;
    __syncthreads();
    for (int i = tid; i < 144 * 136 / 2; i += 512) ((unsigned*)sCt)[i] = 0u;
    __syncthreads();
    bf16x8 Rq[2], Rk[2], Rv[2]; float gli = 0.f, glf = 0.f;
    auto issue = [&](int step) {
        int row0, pos0, seqlen; bool ic; chain_chunk(b, dir, step, row0, pos0, seqlen, ic);
        const int t0 = tp * 2;
        const bf16_t* base = P + (size_t)(row0 + t0) * PLD + h * 128 + vc * 8;
        Rq[0] = *(const bf16x8*)(base + 1536); Rq[1] = *(const bf16x8*)(base + 1536 + PLD);
        Rk[0] = *(const bf16x8*)(base + 2048); Rk[1] = *(const bf16x8*)(base + 2048 + PLD);
        Rv[0] = *(const bf16x8*)(base + 2560); Rv[1] = *(const bf16x8*)(base + 2560 + PLD);
        if (wid == 0) { const int t = dir ? 63 - lane : lane; gli = F[(size_t)(row0 + t) * FLD + (dir * 2) * 4 + h]; glf = F[(size_t)(row0 + t) * FLD + (dir * 2 + 1) * 4 + h]; } };
    issue(0);
    for (int step = 0; step < 36; ++step) {
        int row0, pos0, seqlen; bool is_ctx; chain_chunk(b, dir, step, row0, pos0, seqlen, is_ctx);
        if (wid == 0) {
            const int j = lane, t = dir ? 63 - j : j;
            const float li = gli + gb_i;
            const float lf = logsig_f(glf + gb_f);
            float bsum = lf;
#pragma unroll
            for (int o = 1; o < 64; o <<= 1) { const float n = __shfl_up(bsum, o); if (j >= o) bsum += n; }
            const float u = li - bsum;
            float pmx = u;
#pragma unroll
            for (int o = 1; o < 64; o <<= 1) { const float n = __shfl_up(pmx, o); if (j >= o) pmx = fmaxf(pmx, n); }
            const float pm63 = __shfl(pmx, 63), bend = __shfl(bsum, 63);
            const float Mx = fmaxf(mcar, pm63);
            const float mt = fmaxf(mcar, pmx);
            sRow[t] = -mt; sU[t] = u; sAw[t] = __expf(mcar - mt); sWs[t] = __expf(u - Mx); sEmt[t] = __expf(-(bsum + mt));
            if (j == 0) sScal[0] = __expf(mcar - Mx);
            mcar = bend + Mx;
        }
        {
            const int t0 = tp * 2;
            *(bf16x8*)(sQ + t0 * 136 + vc * 8) = Rq[0]; *(bf16x8*)(sQ + (t0 + 1) * 136 + vc * 8) = Rq[1];
            *(bf16x8*)(sK + t0 * 136 + vc * 8) = Rk[0]; *(bf16x8*)(sK + (t0 + 1) * 136 + vc * 8) = Rk[1];
            *(bf16x8*)(sV + t0 * 136 + vc * 8) = Rv[0]; *(bf16x8*)(sV + (t0 + 1) * 136 + vc * 8) = Rv[1];
            if (step + 1 < 36) issue(step + 1);
        }
        __syncthreads();
        { const int tm = wid >> 1;
#pragma unroll
          for (int q = 0; q < 2; ++q) { const int tn = (wid & 1) * 2 + q; f32x4 acc = (f32x4){0.f, 0.f, 0.f, 0.f};
#pragma unroll
              for (int kk = 0; kk < 128; kk += 32) acc = mfma16(ldsfrag(sQ, 136, tm * 16 + l15, kk + lq * 8), ldsfrag(sK, 136, tn * 16 + l15, kk + lq * 8), acc);
              const int s_ = tn * 16 + l15; const float us = sU[s_];
#pragma unroll
              for (int r = 0; r < 4; ++r) { const int t = tm * 16 + lq * 4 + r; const bool keep = dir ? (s_ >= t) : (s_ <= t);
                  sSc[t * 72 + s_] = f2bf1(keep ? acc[r] * __expf(sRow[t] + us) : 0.f); } } }
        __syncthreads();
        f32x4 num[4];
        { const bf16x8 bv0 = tr_frag<136>(sV, 0, wid * 16, l15, lq), bv1 = tr_frag<136>(sV, 32, wid * 16, l15, lq);
#pragma unroll
          for (int tm = 0; tm < 4; ++tm) { f32x4 acc = (f32x4){0.f, 0.f, 0.f, 0.f};
#pragma unroll
              for (int kk = 0; kk < 128; kk += 32) acc = mfma16(ldsfrag(sQ, 136, tm * 16 + l15, kk + lq * 8), ldsfrag(sCt, 136, wid * 16 + l15, kk + lq * 8), acc);
#pragma unroll
              for (int r = 0; r < 4; ++r) acc[r] *= sAw[tm * 16 + lq * 4 + r];
              acc = mfma16(ldsfrag(sSc, 72, tm * 16 + l15, lq * 8), bv0, acc);
              acc = mfma16(ldsfrag(sSc, 72, tm * 16 + l15, 32 + lq * 8), bv1, acc);
              num[tm] = acc; } }
        if (wid < 4) { const int tm = wid; f32x4 acc = (f32x4){0.f, 0.f, 0.f, 0.f};
            const short one = (l15 == 0) ? (short)0x3F80 : (short)0; const bf16x8 ones = {one, one, one, one, one, one, one, one};
#pragma unroll
            for (int kk = 0; kk < 128; kk += 32) acc = mfma16(ldsfrag(sQ, 136, tm * 16 + l15, kk + lq * 8), ldsfrag(sCt, 136, 128 + l15, kk + lq * 8), acc);
#pragma unroll
            for (int r = 0; r < 4; ++r) acc[r] *= sAw[tm * 16 + lq * 4 + r];
#pragma unroll
            for (int kk = 0; kk < 64; kk += 32) acc = mfma16(ldsfrag(sSc, 72, tm * 16 + l15, kk + lq * 8), ones, acc);
            if (l15 == 0) {
#pragma unroll
                for (int r = 0; r < 4; ++r) sDen[tm * 16 + lq * 4 + r] = acc[r]; } }
        __syncthreads();
#pragma unroll
        for (int tm = 0; tm < 4; ++tm) {
#pragma unroll
            for (int r = 0; r < 4; ++r) { const int t = tm * 16 + lq * 4 + r; const float dn = fmaxf(fabsf(sDen[t]), sEmt[t]);
                sH[t * 136 + wid * 16 + l15] = f2bf1(num[tm][r] * __builtin_amdgcn_rcpf(dn)); } }
        { const float decay = sScal[0];
          bf16x8 bw[2], bn[2];
#pragma unroll
          for (int q = 0; q < 2; ++q) { float xv[8], wv[8]; unpack8(tr_frag<136>(sV, 32 * q, wid * 16, l15, lq), xv);
#pragma unroll
              for (int e = 0; e < 8; ++e) { const float w_ = sWs[32 * q + lq * 8 + e]; xv[e] *= w_; wv[e] = (l15 == 0) ? w_ : 0.f; }
              bw[q] = packf8(xv); bn[q] = packf8(wv); }
#pragma unroll
          for (int kb = 0; kb < 8; ++kb) { C[kb] *= decay;
#pragma unroll
              for (int q = 0; q < 2; ++q) C[kb] = mfma16(tr_frag<136>(sK, 32 * q, kb * 16, l15, lq), bw[q], C[kb]);
              *(uint2*)(sCt + (wid * 16 + l15) * 136 + kb * 16 + lq * 4) = pack4(C[kb]); }
          Cn *= decay;
#pragma unroll
          for (int q = 0; q < 2; ++q) Cn = mfma16(tr_frag<136>(sK, 32 * q, wid * 16, l15, lq), bn[q], Cn);
          *(uint2*)(sCt + (128 + l15) * 136 + wid * 16 + lq * 4) = pack4(Cn); }
        __syncthreads();
#pragma unroll
        for (int i = 0; i < 2; ++i) { const int v = tid + 512 * i, row = v >> 4, cv = v & 15;
            *(bf16x8*)(R2 + (size_t)(row0 + row) * 1024 + dir * 512 + h * 128 + cv * 8) = *(const bf16x8*)(sH + row * 136 + cv * 8); }
    }
}

DEVI void phase_ssd_conv(const Params& p, unsigned char* shm) {
    f32x4* sCwAll = (f32x4*)shm;
    const int tid = tid_l();
    const bf16_t* XBC = (const bf16_t*)(WSP() + OFF_XBC);
    bf16_t* XC = (bf16_t*)(WSP() + OFF_XBCC);
    { const float* cw = INP(24); const float* cb = INP(25);
      for (int i = tid; i < 3072; i += 512) sCwAll[i] = (f32x4){cw[i], cw[3072 + i], cw[6144 + i], cb[i]}; }
    __syncthreads();
    const int ntask = (SLABM / 2) * 384;
    for (int i = bid_l() * 512 + tid; i < ntask; i += gridDim.x * 512) {
        const int v = i % 384, pr = i / 384, r0 = pr * 2;
        int pos, seqlen;
        if (r0 < SLABL) { pos = r0 & (TL - 1); seqlen = TL; } else { pos = (r0 - SLABL) & (TC - 1); seqlen = TC; }
        const bool v0 = pos >= 1, v3 = pos + 2 < seqlen;
        const bf16_t* base = XBC + (size_t)r0 * 3072 + v * 8;
        const long om = v0 ? -3072l : 0l, o3 = v3 ? 6144l : 3072l;
        const bf16x8 a0 = *(const bf16x8*)(base + om), a1 = *(const bf16x8*)(base), a2 = *(const bf16x8*)(base + 3072), a3 = *(const bf16x8*)(base + o3);
        bf16x8 oa, ob; conv2x8(a0, a1, a2, a3, v0, v3, sCwAll + v * 8, oa, ob);
        *(bf16x8*)(XC + (size_t)r0 * 3072 + v * 8) = oa; *(bf16x8*)(XC + (size_t)(r0 + 1) * 3072 + v * 8) = ob;
    }
}

DEVI void ssd_chain(const Params& p, int slab, int lb, int g, int hp, int dir, unsigned char* shm) {
    bf16_t* sC = (bf16_t*)shm;
    bf16_t* sB = sC + 64 * 136;
    bf16_t* sX = sB + 64 * 136;
    bf16_t* sW = sX + 64 * 136;
    bf16_t* sS = sW + 2 * 64 * 72;
    float* sCum = (float*)(sS + 2 * 64 * 136);
    float* sDt = sCum + 128;
    float* sWend = sDt + 128;
    float* sEcum = sWend + 128;
    float* sDec = sEcum + 128;
    f32x4* sCw = (f32x4*)(sDec + 4);
    const int tid = tid_l(), wid = tid >> 6, lane = tid & 63, l15 = lane & 15, lq = lane >> 4;
    const bf16_t* XBC = (const bf16_t*)(WSP() + OFF_XBCC);
    const float* DT = (const float*)(WSP() + OFF_DT);
    bf16_t* Y = (bf16_t*)(WSP() + (dir ? OFF_YB : OFF_YF));
    const int h0 = g * 8 + hp * 2;
    const int vc = tid & 15, tp = tid >> 4;
    const int hh = wid >> 2, pq = wid & 3;
    const int hmine = h0 + hh;
    const float Dh = INP(28)[hmine];
    const int hdt = h0 + (wid & 1);
    const float dtb = INP(26)[dir * 32 + hdt], Ah = -__expf(INP(27)[dir * 32 + hdt]);
    f32x4 St[8];
#pragma unroll
    for (int i = 0; i < 8; ++i) St[i] = (f32x4){0.f, 0.f, 0.f, 0.f};
    __syncthreads();
    for (int i = tid; i < 2 * 64 * 136 / 2; i += 512) ((unsigned*)sS)[i] = 0u;
    __syncthreads();
    bf16x8 R[3][2]; float dtr = 0.f;
    auto chunk_of = [&](int step, int& pos0, int& seqlen, int& lrow0, bool& is_ctx) {
        if (step < 4) { const int cc = dir ? 3 - step : step; is_ctx = true; pos0 = cc * 64; seqlen = TC; lrow0 = SLABL + lb * TC + pos0; }
        else { const int cc = dir ? 31 - (step - 4) : (step - 4); is_ctx = false; pos0 = cc * 64; seqlen = TL; lrow0 = lb * TL + pos0; } };
    auto issue = [&](int step) {
        int pos0, seqlen, lrow0; bool ic; chunk_of(step, pos0, seqlen, lrow0, ic);
        const int t0 = tp * 2;
        const bf16_t* base = XBC + (size_t)(lrow0 + t0) * 3072 + vc * 8;
#pragma unroll
        for (int m = 0; m < 3; ++m) { const int cb = (m == 0 ? 2048 + g * 128 : (m == 1 ? 2560 + g * 128 : h0 * 64));
            R[m][0] = *(const bf16x8*)(base + cb); R[m][1] = *(const bf16x8*)(base + cb + 3072); }
        if (wid < 2) { const int t = dir ? 63 - lane : lane; dtr = DT[(size_t)(lrow0 + t) * 64 + dir * 32 + hdt]; } };
    issue(0);
    for (int step = 0; step < 36; ++step) {
        int pos0, seqlen, lrow0; bool is_ctx; chunk_of(step, pos0, seqlen, lrow0, is_ctx);
        if (wid < 2) {
            const int j = lane, t = dir ? 63 - j : j;
            const float dt = softplus_f(dtr + dtb);
            float cum = dt * Ah;
#pragma unroll
            for (int o = 1; o < 64; o <<= 1) { const float n = __shfl_up(cum, o); if (j >= o) cum += n; }
            const float cend = __shfl(cum, 63);
            sCum[wid * 64 + t] = cum; sDt[wid * 64 + t] = dt; sWend[wid * 64 + t] = __expf(cend - cum) * dt; sEcum[wid * 64 + t] = __expf(cum);
            if (j == 0) sDec[wid] = __expf(cend);
        }
        {
            const int t0 = tp * 2;
#pragma unroll
            for (int m = 0; m < 3; ++m) {
                if (m == 1 && is_ctx) continue;
                bf16_t* dst = (m == 0 ? sB : (m == 1 ? sC : sX));
                *(bf16x8*)(dst + t0 * 136 + vc * 8) = R[m][0]; *(bf16x8*)(dst + (t0 + 1) * 136 + vc * 8) = R[m][1]; }
            if (step + 1 < 36) issue(step + 1);
        }
        __syncthreads();
        if (!is_ctx) { const int tm = wid >> 1;
#pragma unroll
          for (int q = 0; q < 2; ++q) { const int tn = (wid & 1) * 2 + q; f32x4 acc = (f32x4){0.f, 0.f, 0.f, 0.f};
#pragma unroll
              for (int kk = 0; kk < 128; kk += 32) acc = mfma16(ldsfrag(sC, 136, tm * 16 + l15, kk + lq * 8), ldsfrag(sB, 136, tn * 16 + l15, kk + lq * 8), acc);
              const int s_ = tn * 16 + l15;
#pragma unroll
              for (int h2 = 0; h2 < 2; ++h2) { const float cs = sCum[h2 * 64 + s_], ds = sDt[h2 * 64 + s_]; const f32x4 ct = *(const f32x4*)(sCum + h2 * 64 + tm * 16 + lq * 4);
#pragma unroll
                  for (int r = 0; r < 4; ++r) { const int t = tm * 16 + lq * 4 + r; const bool keep = dir ? (s_ >= t) : (s_ <= t);
                      sW[(h2 * 64 + t) * 72 + s_] = f2bf1(keep ? acc[r] * __expf(ct[r] - cs) * ds : 0.f); } } } }
        if (!is_ctx) __syncthreads();
        const bf16_t* sSh = sS + hh * 64 * 136;
        const bf16x8 bx0 = tr_frag<136>(sX, 0, hh * 64 + pq * 16, l15, lq), bx1 = tr_frag<136>(sX, 32, hh * 64 + pq * 16, l15, lq);
        if (!is_ctx) {
#pragma unroll
            for (int tm = 0; tm < 4; ++tm) { f32x4 acc = (f32x4){0.f, 0.f, 0.f, 0.f};
#pragma unroll
                for (int kk = 0; kk < 128; kk += 32) acc = mfma16(ldsfrag(sC, 136, tm * 16 + l15, kk + lq * 8), ldsfrag(sSh, 136, pq * 16 + l15, kk + lq * 8), acc);
                { const f32x4 ec = *(const f32x4*)(sEcum + hh * 64 + tm * 16 + lq * 4);
#pragma unroll
                  for (int r = 0; r < 4; ++r) acc[r] *= ec[r]; }
                acc = mfma16(ldsfrag(sW, 72, hh * 64 + tm * 16 + l15, lq * 8), bx0, acc);
                acc = mfma16(ldsfrag(sW, 72, hh * 64 + tm * 16 + l15, 32 + lq * 8), bx1, acc);
                if (!dir) {
#pragma unroll
                    for (int r = 0; r < 4; ++r) acc[r] += Dh * bf2f(sX[(tm * 16 + lq * 4 + r) * 136 + hh * 64 + pq * 16 + l15]); }
#pragma unroll
                for (int r = 0; r < 4; ++r) Y[(size_t)(lrow0 + tm * 16 + lq * 4 + r) * 2048 + hmine * 64 + pq * 16 + l15] = f2bf1(acc[r]); }
        }
        { bf16x8 bx[2];
#pragma unroll
          for (int q = 0; q < 2; ++q) { float xv[8]; unpack8(q ? bx1 : bx0, xv);
#pragma unroll
              for (int e = 0; e < 8; ++e) xv[e] *= sWend[hh * 64 + q * 32 + lq * 8 + e];
              bx[q] = packf8(xv); }
          const float dec = sDec[hh];
#pragma unroll
          for (int nb = 0; nb < 8; ++nb) { St[nb] *= dec;
#pragma unroll
              for (int q = 0; q < 2; ++q) St[nb] = mfma16(tr_frag<136>(sB, q * 32, nb * 16, l15, lq), bx[q], St[nb]);
              *(uint2*)(sS + hh * 64 * 136 + (pq * 16 + l15) * 136 + nb * 16 + lq * 4) = pack4(St[nb]); } }
        __syncthreads();
    }
}

DEVI float sum16(float v) { v += __shfl_xor(v, 1); v += __shfl_xor(v, 2); v += __shfl_xor(v, 4); v += __shfl_xor(v, 8); return v; }
DEVI void phase_even_combine(const Params& p) {
    const int tid_ = tid_l(); const int wid = tid_ >> 6, lane = tid_ & 63;
    const bf16_t* P = (const bf16_t*)(WSP() + OFF_P);
    bf16_t* R1 = (bf16_t*)(WSP() + OFF_H);
    const bf16_t* R2 = (const bf16_t*)(WSP() + OFF_R2);
    float gn[8], mn[8];
#pragma unroll
    for (int e = 0; e < 8; ++e) { gn[e] = INP(20)[lane * 8 + e]; mn[e] = INP(21)[lane * 8 + e]; }
    const int stride = gridDim.x * 8;
    int row = bid_l() * 8 + wid;
    bf16x8 c[6], n[6];
    auto ldrow = [&](int r, bf16x8 (&d)[6]) {
        d[0] = *(const bf16x8*)(R1 + (size_t)r * 1024 + lane * 8); d[1] = *(const bf16x8*)(R1 + (size_t)r * 1024 + 512 + lane * 8);
        d[2] = *(const bf16x8*)(P + (size_t)r * PLD + 1024 + lane * 8); d[3] = *(const bf16x8*)(R2 + (size_t)r * 1024 + lane * 8);
        d[4] = *(const bf16x8*)(R2 + (size_t)r * 1024 + 512 + lane * 8); d[5] = *(const bf16x8*)(P + (size_t)r * PLD + 3072 + lane * 8); };
    if (row < MTOT) ldrow(row, c);
    for (; row < MTOT; row += stride) {
        if (row + stride < MTOT) ldrow(row + stride, n);
        float of[8], ob[8], gg[8], hf[8], hb[8], mo[8];
        unpack8(c[0], of); unpack8(c[1], ob); unpack8(c[2], gg); unpack8(c[3], hf); unpack8(c[4], hb); unpack8(c[5], mo);
        float s1 = 0.f, s2 = 0.f;
#pragma unroll
        for (int e = 0; e < 8; ++e) { of[e] += ob[e]; s1 += of[e] * of[e]; hf[e] = sigmoid_f(mo[e]) * (hf[e] + hb[e]); s2 += hf[e] * hf[e]; }
        s1 = sum16(s1); s2 = sum16(s2);
        const float r1 = rsqrtf(s1 * (1.f / 128.f) + 1e-6f), r2 = rsqrtf(s2 * (1.f / 128.f) + 1e-6f);
#pragma unroll
        for (int e = 0; e < 8; ++e) { of[e] = of[e] * r1 * gn[e] * silu_f(gg[e]); hf[e] = hf[e] * r2 * mn[e]; }
        *(bf16x8*)(R1 + (size_t)row * 1024 + lane * 8) = packf8(of);
        *(bf16x8*)(R1 + (size_t)row * 1024 + 512 + lane * 8) = packf8(hf);
#pragma unroll
        for (int i = 0; i < 6; ++i) c[i] = n[i];
    }
}
DEVI void phase_odd_combine(const Params& p) {
    const int tid_ = tid_l(); const int wid = tid_ >> 6, lane = tid_ & 63;
    bf16_t* Z = (bf16_t*)(WSP() + OFF_Z);
    const bf16_t* YF = (const bf16_t*)(WSP() + OFF_YF);
    const bf16_t* YB = (const bf16_t*)(WSP() + OFF_YB);
    const float* ng = INP(29);
    f32x4 ngv[4][2];
#pragma unroll
    for (int gi = 0; gi < 4; ++gi) { ngv[gi][0] = *(const f32x4*)(ng + gi * 512 + lane * 8); ngv[gi][1] = *(const f32x4*)(ng + gi * 512 + lane * 8 + 4); }
    const int stride = gridDim.x * 8;
    int row = bid_l() * 8 + wid;
    bf16x8 c[12], n[12];
    auto ldrow = [&](int r, bf16x8 (&d)[12]) {
#pragma unroll
        for (int gi = 0; gi < 4; ++gi) { const int ch = gi * 512 + lane * 8;
            d[gi * 3] = *(const bf16x8*)(YF + (size_t)r * 2048 + ch); d[gi * 3 + 1] = *(const bf16x8*)(YB + (size_t)r * 2048 + ch); d[gi * 3 + 2] = *(const bf16x8*)(Z + (size_t)r * 2048 + ch); } };
    if (row < SLABL) ldrow(row, c);
    for (; row < SLABL; row += stride) {
        if (row + stride < SLABL) ldrow(row + stride, n);
#pragma unroll
        for (int gi = 0; gi < 4; ++gi) { const int ch = gi * 512 + lane * 8; float yf[8], yb[8], z[8];
            unpack8(c[gi * 3], yf); unpack8(c[gi * 3 + 1], yb); unpack8(c[gi * 3 + 2], z);
            float ss = 0.f;
#pragma unroll
            for (int e = 0; e < 8; ++e) { yf[e] = (yf[e] + yb[e]) * silu_f(z[e]); ss += yf[e] * yf[e]; }
            ss = wave_sum(ss);
            const float rs = rsqrtf(ss * (1.f / 512.f) + 1e-6f);
#pragma unroll
            for (int e = 0; e < 8; ++e) yf[e] = yf[e] * rs * ngv[gi][e >> 2][e & 3];
            *(bf16x8*)(Z + (size_t)row * 2048 + ch) = packf8(yf); }
#pragma unroll
        for (int i = 0; i < 12; ++i) c[i] = n[i];
    }
}

DEVI void phase_convact(const Params& p, int layer, int grp, bool with_ctx) {
    const int tid = tid_l(), wid = tid >> 6, lane = tid & 63;
    const int w = grp == 2 ? 768 : 1024, j0 = grp * 1024, ldu = 2 * w, nvb = w / 256;
    const int segw = grp == 2 ? 8 : 32, nseg = 64 / segw;
    const bf16_t* U = (const bf16_t*)(WSP() + OFF_U);
    bf16_t* ACT = (bf16_t*)(WSP() + OFF_ACT);
    const float* cw = INP(10) + (size_t)layer * 9 * NUP;
    const float* cbias = INP(11) + (size_t)layer * NUP;
    const int nlat = 16 * 2 * nvb * nseg, nctx = with_ctx ? 16 * nvb * 4 : 0;
    for (int u = bid_l(); u < nlat + nctx; u += gridDim.x) {
        int img_row0, H, Wd, r0, c0, nc, vb;
        if (u < nlat) { int q = u; const int seg = q % nseg; q /= nseg; vb = q % nvb; q /= nvb; const int band = q & 1; const int img = q >> 1;
            img_row0 = img * TL; H = 32; Wd = 64; r0 = band * 16 + wid * 2; c0 = seg * segw; nc = segw; }
        else { int q = u - nlat; const int quarter = q & 3; q >>= 2; vb = q % nvb; const int img = q / nvb; img_row0 = MLAT + img * TC; H = 1; Wd = 256; r0 = 0; c0 = quarter * 64 + wid * 8; nc = 8; }
        const bool two = (r0 + 1 < H);
        const int j = vb * 256 + lane * 4;
        const int cha = j0 + j, chg = 2816 + j0 + j;
        float wa[9][4], wg[9][4], ba[4], bg[4];
#pragma unroll
        for (int q = 0; q < 9; ++q) { const f32x4 a = *(const f32x4*)(cw + q * NUP + cha), g = *(const f32x4*)(cw + q * NUP + chg);
#pragma unroll
            for (int e = 0; e < 4; ++e) { wa[q][e] = a[e]; wg[q][e] = g[e]; } }
        { const f32x4 a = *(const f32x4*)(cbias + cha), g = *(const f32x4*)(cbias + chg);
#pragma unroll
          for (int e = 0; e < 4; ++e) { ba[e] = a[e]; bg[e] = g[e]; } }
        f32x4 Wa[4][3], Wg[4][3]; uint2 Na[4], Ng[4];
        auto ld = [&](int rr, int cc, uint2& va, uint2& vg) {
            const bool ok = rr >= 0 && rr < H && cc >= 0 && cc < Wd;
            const int rc = min(max(rr, 0), H - 1), ccl = min(max(cc, 0), Wd - 1);
            const bf16_t* q = U + (size_t)(img_row0 + rc * Wd + ccl) * ldu + j; va = *(const uint2*)q; vg = *(const uint2*)(q + w);
            if (!ok) { va = make_uint2(0u, 0u); vg = make_uint2(0u, 0u); } };
        auto up = [&](uint2 a) { f32x4 r; r[0] = __uint_as_float(a.x << 16); r[1] = __uint_as_float(a.x & 0xFFFF0000u); r[2] = __uint_as_float(a.y << 16); r[3] = __uint_as_float(a.y & 0xFFFF0000u); return r; };
#pragma unroll
        for (int dy = 0; dy < 4; ++dy) { uint2 a, g; ld(r0 + dy - 1, c0 - 1, a, g); Wa[dy][1] = up(a); Wg[dy][1] = up(g); ld(r0 + dy - 1, c0, a, g); Wa[dy][2] = up(a); Wg[dy][2] = up(g); ld(r0 + dy - 1, c0 + 1, Na[dy], Ng[dy]); }
#pragma unroll 6
        for (int cc = c0; cc < c0 + nc; ++cc) {
#pragma unroll
            for (int dy = 0; dy < 4; ++dy) { Wa[dy][0] = Wa[dy][1]; Wa[dy][1] = Wa[dy][2]; Wa[dy][2] = up(Na[dy]); Wg[dy][0] = Wg[dy][1]; Wg[dy][1] = Wg[dy][2]; Wg[dy][2] = up(Ng[dy]); }
#pragma unroll
            for (int dy = 0; dy < 4; ++dy) ld(r0 + dy - 1, cc + 2, Na[dy], Ng[dy]);
            float sa[2][4], sg[2][4];
#pragma unroll
            for (int o = 0; o < 2; ++o)
#pragma unroll
                for (int e = 0; e < 4; ++e) { sa[o][e] = ba[e]; sg[o][e] = bg[e]; }
#pragma unroll
            for (int dy = 0; dy < 4; ++dy)
#pragma unroll
                for (int dx = 0; dx < 3; ++dx) { const f32x4 a = Wa[dy][dx], g = Wg[dy][dx];
                    if (dy < 3) { const int q = dy * 3 + dx;
#pragma unroll
                        for (int e = 0; e < 4; ++e) { sa[0][e] += wa[q][e] * a[e]; sg[0][e] += wg[q][e] * g[e]; } }
                    if (dy >= 1) { const int q = (dy - 1) * 3 + dx;
#pragma unroll
                        for (int e = 0; e < 4; ++e) { sa[1][e] += wa[q][e] * a[e]; sg[1][e] += wg[q][e] * g[e]; } } }
            { uint2 o; o.x = pack2(silu_f(sg[0][0]) * sa[0][0], silu_f(sg[0][1]) * sa[0][1]); o.y = pack2(silu_f(sg[0][2]) * sa[0][2], silu_f(sg[0][3]) * sa[0][3]);
              *(uint2*)(ACT + (size_t)(img_row0 + r0 * Wd + cc) * DFF + j0 + j) = o; }
            if (two) { uint2 o; o.x = pack2(silu_f(sg[1][0]) * sa[1][0], silu_f(sg[1][1]) * sa[1][1]); o.y = pack2(silu_f(sg[1][2]) * sa[1][2], silu_f(sg[1][3]) * sa[1][3]);
              *(uint2*)(ACT + (size_t)(img_row0 + (r0 + 1) * Wd + cc) * DFF + j0 + j) = o; }
        }
    }
}

#define XB_TMO      128
#define XB_XCNT(j)  (256  + 64 * (j))
#define XB_XSUB(j)  (1280 + 64 * (j))
#define XB_XGEN(j)  (2304 + 64 * (j))
#define XB_TOP      3328
#define XB_TOPGEN   3392
#define XCD_BAR_WORDS 3456
#define XB_SPIN_CAP (1u << 22)
DEVI unsigned xb_ld(unsigned* p)              { return __hip_atomic_load(p, __ATOMIC_RELAXED, __HIP_MEMORY_SCOPE_AGENT); }
DEVI unsigned xb_add(unsigned* p, unsigned v) { return __hip_atomic_fetch_add(p, v, __ATOMIC_RELAXED, __HIP_MEMORY_SCOPE_AGENT); }
DEVI unsigned xb_xcc_id() { return (unsigned)__builtin_amdgcn_s_getreg((3 << 11) | 20) & 0xFu; }
#define XB_SPIN(cond, bar) do { unsigned _sp = 0; while (cond) { __builtin_amdgcn_s_sleep(1); \
    if ((++_sp & 255u) == 0u) { if (xb_ld(&(bar)[XB_TMO])) break; if (_sp > XB_SPIN_CAP) { atomicAdd(&(bar)[XB_TMO], 1u); break; } } } } while (0)
struct XcdBarrier { unsigned* bar; unsigned x; volatile LAS unsigned* st; };
DEVI XcdBarrier xcd_barrier_post(unsigned* bar, volatile LAS unsigned* st) {
    XcdBarrier b; b.bar = bar; b.x = xb_xcc_id(); b.st = st;
    if (threadIdx.x == 0) (void)xb_add(&bar[XB_XCNT(b.x)], 1u);
    return b;
}
DEVI void xcd_barrier_complete(unsigned* bar, unsigned x, unsigned& nloc, unsigned& nx) {
    const unsigned G = gridDim.x * gridDim.y * gridDim.z;
    unsigned sum, cnt, mine, sp = 0u;
    for (;;) {
        sum = 0u; cnt = 0u; mine = 0u;
#pragma unroll
        for (unsigned j = 0; j < 16; ++j) { const unsigned c = xb_ld(&bar[XB_XCNT(j)]); sum += c; cnt += (c > 0u) ? 1u : 0u; mine = (j == x) ? c : mine; }
        if (sum == G) break;
        __builtin_amdgcn_s_sleep(1);
        if ((++sp & 255u) == 0u) { if (xb_ld(&bar[XB_TMO])) break; if (sp > XB_SPIN_CAP) { atomicAdd(&bar[XB_TMO], 1u); break; } }
    }
    nloc = mine > 0u ? mine : 1u; nx = cnt > 0u ? cnt : 1u;
}
DEVI void xcd_barrier(const XcdBarrier& b) {
    asm volatile("s_waitcnt vmcnt(0)" ::: "memory");
    __syncthreads();
    if (threadIdx.x == 0) {
        unsigned* bar = b.bar;
        __builtin_amdgcn_s_waitcnt(0);
        unsigned nloc = b.st[0], nx = b.st[1];
        if (nloc == 0u) { xcd_barrier_complete(bar, b.x, nloc, nx); b.st[0] = nloc; b.st[1] = nx; }
        const unsigned old = xb_add(&bar[XB_XSUB(b.x)], 1u);
        const unsigned gen = old / nloc;
        if (old + 1u == (gen + 1u) * nloc) {
            __builtin_amdgcn_fence(__ATOMIC_RELEASE, "agent");
            asm volatile("s_waitcnt vmcnt(0)" ::: "memory");
            const unsigned og = xb_add(&bar[XB_TOP], 1u);
            const unsigned tg = og / nx;
            if (og + 1u == (tg + 1u) * nx) xb_add(&bar[XB_TOPGEN], 1u);
            else XB_SPIN(xb_ld(&bar[XB_TOPGEN]) == tg, bar);
            __builtin_amdgcn_fence(__ATOMIC_ACQUIRE, "agent");
            xb_add(&bar[XB_XGEN(b.x)], 1u);
            asm volatile("s_waitcnt vmcnt(0)" ::: "memory");
        } else {
            XB_SPIN(xb_ld(&bar[XB_XGEN(b.x)]) == gen, bar);
            __builtin_amdgcn_fence(__ATOMIC_ACQUIRE, "agent");
            asm volatile("s_waitcnt vmcnt(0)" ::: "memory");
        }
    }
    __syncthreads();
}
constexpr size_t OFF_BAR = OFF_MOD + 900 * 1024;
constexpr int LDS_CTL = 131072 + 64;

#ifndef ONLYG
#define ONLYG -1
#endif
#define GEN(x) (ONLYG < 0 || ONLYG == (x))
#ifndef REP
#define REP 0
#endif
#define REPEAT(bit, ...) do { __VA_ARGS__; if (REP & (bit)) { xcd_barrier(xbar); __VA_ARGS__; } } while (0)
__global__ void __launch_bounds__(512) mega(Params p) {
    extern __shared__ __attribute__((aligned(16))) unsigned char shm[];
    volatile LAS unsigned* xst = (volatile LAS unsigned*)((LAS unsigned char*)shm + LDS_CTL);
    if (threadIdx.x == 0) { xst[0] = 0u; xst[1] = 0u; }
    __syncthreads();
    XcdBarrier xbar = xcd_barrier_post((unsigned*)(WSP() + OFF_BAR), xst);
    int ph = 0;
#define PH_BEGIN if (ph >= PH_LO() && ph < PH_HI()) { unsigned char* ws = WSP(); bf16_t* Wb = (bf16_t*)(ws + OFF_W); bf16_t* Hb = (bf16_t*)(ws + OFF_H); float* Xc = (float*)(ws + OFF_XC); const float* MOD = (const float*)(ws + OFF_MOD); (void)Wb; (void)Hb; (void)Xc; (void)MOD;
#define PH_END if (ph + 1 < PH_HI()) { xcd_barrier(xbar); } } ++ph;
    PH_BEGIN if (GEN(0)) REPEAT(16, phase_prep(p, shm)); PH_END
    PH_BEGIN if (GEN(1)) REPEAT(64, phase_modulate(p, INP(0), INP(2), MTOT, INP(6), 0, 0, OUTP(), Xc)); PH_END
    PH_BEGIN if (GEN(2)) { EpiInL0 e{(bf16_t*)(ws + OFF_P), (float*)(ws + OFF_F32), (bf16_t*)(ws + OFF_R2)}; run_gemm(shm, Hb, Wb + W0IN, MTOT, N0IN, 1024, e); } PH_END
    PH_BEGIN if (GEN(3) || ONLYG == 33) phase_ml_conv(p, shm); PH_END
    PH_BEGIN
        REPEAT(1, for (int u = bid_l(); u < 256; u += gridDim.x) {
            const int s_ = (u & 7) + 8 * ((u >> 3) & 15), dir = u >> 7, kind = s_ & 1, h = (s_ >> 1) & 3, b = s_ >> 3;
            if (kind == 0) { if (GEN(3) || ONLYG == 33) mlstm_chain(p, b, h, dir, shm); } else { if (GEN(3) || ONLYG == 34) gla_chain(p, b, h, dir, shm); }
        });
    PH_END
    PH_BEGIN if (GEN(4)) phase_even_combine(p); PH_END
    PH_BEGIN if (GEN(5)) { EpiResid e{OUTP(), Xc, MOD, 2048, 0}; run_gemm(shm, Hb, Wb + W0OUT, MLAT, 1024, 1024, e); } PH_END
    PH_BEGIN
        if ((int)bid_l() < 64) { if (GEN(5)) { EpiResid e{OUTP(), Xc, MOD, 2048, MLAT}; run_gemm(shm, Hb + (size_t)MLAT * DM, Wb + W0OUT, MCTX, 1024, 1024, e, 1 << 30, 0, 0, 64); } }
        else { if (GEN(1)) phase_modulate(p, OUTP(), Xc, MLAT, INP(7), 0, 3072, nullptr, nullptr, 0, 64); }
    PH_END
    PH_BEGIN if (GEN(1)) phase_modulate(p, OUTP(), Xc, MTOT, INP(7), 0, 3072, nullptr, nullptr, MLAT, 0); PH_END
    for (int g = 0; g < 3; ++g) {
        PH_BEGIN if (GEN(7)) { EpiBf16 e{(bf16_t*)(ws + OFF_U), g == 2 ? 1536 : 2048}; REPEAT(8, run_gemm(shm, Hb, Wb + UP0 + (size_t)g * 2048 * 1024, MTOT, g == 2 ? 1536 : 2048, 1024, e)); } PH_END
        PH_BEGIN if (GEN(8)) REPEAT(4, phase_convact(p, 0, g, true)); PH_END
    }
    PH_BEGIN if (GEN(5)) { EpiResid e{OUTP(), Xc, MOD, 5120, 0}; run_gemm(shm, (const bf16_t*)(ws + OFF_ACT), Wb + DN0, MLAT, 1024, DFF, e); } PH_END
    PH_BEGIN
        if ((int)bid_l() < 64) { if (GEN(5)) { EpiResid e{OUTP(), Xc, MOD, 5120, MLAT}; run_gemm(shm, (const bf16_t*)(ws + OFF_ACT) + (size_t)MLAT * DFF, Wb + DN0, MCTX, 1024, DFF, e, 1 << 30, 0, 0, 64); } }
        else { if (GEN(1)) phase_modulate(p, OUTP(), Xc, MLAT, INP(6) + 1024, 1, 0, nullptr, nullptr, 0, 64); }
    PH_END
    PH_BEGIN if (GEN(1)) phase_modulate(p, OUTP(), Xc, MTOT, INP(6) + 1024, 1, 0, nullptr, nullptr, MLAT, 0); PH_END
    for (int slab = 0; slab < 2; ++slab) {
        PH_BEGIN if (GEN(15)) { EpiInL1 e{(bf16_t*)(ws + OFF_XBC), (bf16_t*)(ws + OFF_Z), (float*)(ws + OFF_DT)};
            run_gemm(shm, Hb, Wb + W1IN, SLABM, N1IN, 1024, e, 64, 64 * slab, 128 + 8 * slab); } PH_END
        PH_BEGIN if (GEN(16)) phase_ssd_conv(p, shm); PH_END
        PH_BEGIN if (GEN(16)) REPEAT(2, for (int u = bid_l(); u < 256; u += gridDim.x) { const int s_ = (u & 7) + 8 * ((u >> 3) & 3), j_ = u >> 5, dir = j_ & 1, hp = j_ >> 1, g = s_ & 3, lb = s_ >> 2; ssd_chain(p, slab, lb, g, hp, dir, shm); }); PH_END
        PH_BEGIN if (GEN(17)) phase_odd_combine(p); PH_END
        PH_BEGIN if (GEN(5)) { EpiResid e{OUTP(), Xc, MOD + 17 * 6144, 2048, SLABL * slab}; run_gemm(shm, (const bf16_t*)(ws + OFF_Z), Wb + W1OUT, SLABL, 1024, 2048, e); } PH_END
    }
    PH_BEGIN if (GEN(1)) REPEAT(64, phase_modulate(p, OUTP(), Xc, MLAT, INP(7) + 1024, 1, 3072)); PH_END
    for (int g = 0; g < 3; ++g) {
        PH_BEGIN if (GEN(7)) { EpiBf16 e{(bf16_t*)(ws + OFF_U), g == 2 ? 1536 : 2048}; REPEAT(8, run_gemm(shm, Hb, Wb + UP1 + (size_t)g * 2048 * 1024, MLAT, g == 2 ? 1536 : 2048, 1024, e)); } PH_END
        PH_BEGIN if (GEN(8)) REPEAT(4, phase_convact(p, 1, g, false)); PH_END
    }
    PH_BEGIN if (GEN(5)) { EpiResid e{OUTP(), Xc, MOD + 17 * 6144, 5120, 0}; run_gemm(shm, (const bf16_t*)(ws + OFF_ACT), Wb + DN1, MLAT, 1024, DFF, e); } PH_END
    PH_BEGIN if (REP & 32) { for (int i = 0; i < 20; ++i) cg::this_grid().sync(); } if (GEN(1)) phase_final_norm(p); PH_END
    if (PH_HI() > 4096) cg::this_grid().sync();
}

#ifndef N_LAUNCH_PER_PHASE
#define N_LAUNCH_PER_PHASE 0
#endif

extern "C" void kernel_launch(void* const* d_in, const int* in_sizes, int n_in, void* d_out, int out_size, void* d_ws, size_t ws_size, hipStream_t stream) {
    static int grid = 0;
    if (grid == 0) {
        if (n_in != 31 || ws_size < WS_NEED) { fprintf(stderr, "kernel_launch: unexpected n_in %d or ws_size %zu (< %zu)\n", n_in, ws_size, (size_t)WS_NEED); grid = -1; return; }
        int dev = 0, cus = 0, per_cu = 0;
        hipGetDevice(&dev);
        hipDeviceGetAttribute(&cus, hipDeviceAttributeMultiprocessorCount, dev);
        if (hipFuncSetAttribute((const void*)mega, hipFuncAttributeMaxDynamicSharedMemorySize, LDS_BYTES) != hipSuccess) { fprintf(stderr, "kernel_launch: hipFuncSetAttribute failed\n"); grid = -1; return; }
        hipOccupancyMaxActiveBlocksPerMultiprocessor(&per_cu, (const void*)mega, 512, LDS_BYTES);
        if (per_cu < 1) { fprintf(stderr, "kernel_launch: occupancy query says %d blocks per CU\n", per_cu); per_cu = 1; }
        (void)hipGetLastError();
        grid = cus * 1;
    }
    if (grid < 0) return;
    Params p{};
    for (int i = 0; i < 31; ++i) p.in[i] = (const float*)d_in[i];
    p.out = (float*)d_out; p.ws = (unsigned char*)d_ws;
#if N_LAUNCH_PER_PHASE
    for (int ph = 0; ph < NPHASE; ++ph) {
        p.ph_lo = ph; p.ph_hi = ph + 1;
        hipLaunchKernelGGL(mega, dim3(grid), dim3(512), LDS_BYTES, stream, p);
    }
#else
    p.ph_lo = 0; p.ph_hi = NPHASE;
    if (hipMemsetAsync((unsigned char*)d_ws + OFF_BAR, 0, XCD_BAR_WORDS * 4, stream) != hipSuccess) { fprintf(stderr, "kernel_launch: memset of barrier words failed\n"); return; }
    void* args[] = {&p};
    hipError_t e = hipLaunchCooperativeKernel((const void*)mega, dim3(grid), dim3(512), args, LDS_BYTES, stream);
    if (e != hipSuccess) fprintf(stderr, "cooperative launch failed: %s (grid %d)\n", hipGetErrorString(e), grid);
#endif
}
```
